# Optimizing an MI355X kernel written in HIP

```python
import math
import jax, jax.numpy as jnp
from jax import lax
import numpy as np

D_MODEL = 1024
BATCH = 8
SEQ = 2048
DEPTH = 1

HEAD_DIM = 64
N_HEADS_A = 8
N_HEADS_B = 8
D_A = N_HEADS_A * HEAD_DIM
D_B = N_HEADS_B * HEAD_DIM
D_MIX = D_A + D_B
N_IN = 3 * D_A + 3 * D_B + N_HEADS_B
DILATED_PATTERNS = ((128, 1), (512, 4), (2048, 16))
ROPE_THETA = 500000.0
ROT_DIM = HEAD_DIM // 4
Q_BLOCK = 128
N_GROUPS = 4
EXPERTS_PER_GROUP = 8
N_EXPERTS = N_GROUPS * EXPERTS_PER_GROUP
TOP_K = 2
D_EXPERT = 512
PLE_DIM = 256
EPS = 1e-6
NEG = -1e30
FORGET_BIAS = 2.5

kernel_name = "hymba_dilated_fox_hmoe_block"


def rmsnorm(x, g):
    xf = x.astype(jnp.float32)
    y = xf * lax.rsqrt(jnp.mean(xf * xf, axis=-1, keepdims=True) + EPS)
    return (y * g.astype(jnp.float32)).astype(x.dtype)


def rope_tables(positions):
    pos = positions.astype(jnp.float32)
    inv = ROPE_THETA ** (-jnp.arange(0, ROT_DIM, 2, dtype=jnp.float32) / ROT_DIM)
    ang = pos[..., None] * inv
    return jnp.cos(ang)[:, :, None, :], jnp.sin(ang)[:, :, None, :]


def partial_rope(t, cos, sin):
    half = ROT_DIM // 2
    tf = t.astype(jnp.float32)
    t1, t2, rest = tf[..., :half], tf[..., half:ROT_DIM], tf[..., ROT_DIM:]
    out = jnp.concatenate([t1 * cos - t2 * sin, t2 * cos + t1 * sin, rest], axis=-1)
    return out.astype(t.dtype)


def dilated_window_attention(q, k, v, window, dilation):
    B, S, H, Dh = q.shape
    d = dilation
    W = window // d
    L = S // d
    nb = -(-L // W)
    pad = nb * W - L

    def to_blocks(a):
        a = a.reshape(B, L, d, H, Dh).transpose(0, 2, 1, 3, 4).reshape(B * d, L, H, Dh)
        a = jnp.pad(a, ((0, 0), (0, pad), (0, 0), (0, 0)))
        return a.reshape(B * d, nb, W, H, Dh)

    def with_prev(a):
        prev = jnp.pad(a, ((0, 0), (1, 0), (0, 0), (0, 0), (0, 0)))[:, :-1]
        return jnp.concatenate([prev, a], axis=2)

    qb, kb, vb = to_blocks(q), to_blocks(k), to_blocks(v)
    kc, vc = with_prev(kb), with_prev(vb)
    s = jnp.einsum('znqhd,znkhd->znhqk', qb, kc).astype(jnp.float32) / math.sqrt(Dh)
    qi = jnp.arange(W)[:, None]
    kj = jnp.arange(2 * W)[None, :]
    dist = qi + W - kj
    band = (dist >= 0) & (dist <= W)
    valid = (jnp.arange(nb)[:, None, None] > 0) | (kj[None] >= W)
    mask = band[None] & valid
    s = jnp.where(mask[None, :, None], s, NEG)
    m = jnp.max(s, axis=-1, keepdims=True)
    e = jnp.exp(s - m)
    den = jnp.sum(e, axis=-1)
    o = jnp.einsum('znhqk,znkhd->znqhd', e, vc.astype(jnp.float32))
    o = o / jnp.transpose(den, (0, 1, 3, 2))[..., None]
    lse = jnp.transpose(m[..., 0] + jnp.log(den), (0, 1, 3, 2))
    o = o.reshape(B * d, nb * W, H, Dh)[:, :L]
    o = o.reshape(B, d, L, H, Dh).transpose(0, 2, 1, 3, 4).reshape(B, S, H, Dh)
    lse = lse.reshape(B * d, nb * W, H)[:, :L]
    lse = lse.reshape(B, d, L, H).transpose(0, 2, 1, 3).reshape(B, S, H)
    return o, lse


def forgetting_attention(q, k, v, logf):
    B, S, H, Dh = q.shape
    c = jnp.cumsum(logf, axis=1)
    cT = jnp.transpose(c, (0, 2, 1))
    nq = S // Q_BLOCK
    qblk = q.reshape(B, nq, Q_BLOCK, H, Dh).transpose(1, 0, 2, 3, 4)
    cblk = cT.reshape(B, H, nq, Q_BLOCK).transpose(2, 0, 1, 3)
    starts = jnp.arange(nq, dtype=jnp.int32) * Q_BLOCK
    kpos = jnp.arange(S, dtype=jnp.int32)
    vf = v.astype(jnp.float32)
    scale = 1.0 / math.sqrt(Dh)

    def block(args):
        qi, ci, st = args
        s = jnp.einsum('bqhd,bkhd->bhqk', qi, k).astype(jnp.float32) * scale
        s = s + (ci[..., :, None] - cT[:, :, None, :])
        qpos = st + jnp.arange(Q_BLOCK, dtype=jnp.int32)
        s = jnp.where(kpos[None, :] <= qpos[:, None], s, NEG)
        pr = jax.nn.softmax(s, axis=-1)
        return jnp.einsum('bhqk,bkhd->bqhd', pr, vf)

    o = lax.map(block, (qblk, cblk, starts))
    return o.transpose(1, 0, 2, 3, 4).reshape(B, S, H, Dh)


def hierarchical_moe(m, w_rg, b_rg, w_re, b_re, w_up, w_down):
    lg = (jnp.einsum('bsd,dg->bsg', m, w_rg) + b_rg).astype(jnp.float32)
    pg = jax.nn.softmax(lg, axis=-1)
    gidx = jnp.argmax(lg, axis=-1)
    gw = jnp.take_along_axis(pg, gidx[..., None], axis=-1)[..., 0]
    le = (jnp.einsum('bsd,gde->bsge', m, w_re) + b_re).astype(jnp.float32)
    le_sel = jnp.take_along_axis(le, gidx[..., None, None], axis=2)[:, :, 0]
    top_v, top_i = lax.top_k(le_sel, TOP_K)
    tw = jax.nn.softmax(top_v, axis=-1) * gw[..., None]
    eid = gidx[..., None] * EXPERTS_PER_GROUP + top_i
    gate = jnp.sum(jax.nn.one_hot(eid, N_EXPERTS, dtype=jnp.float32) * tw[..., None], axis=-2)
    y = jnp.zeros(m.shape, jnp.float32)
    for e in range(N_EXPERTS):
        hu = jnp.einsum('bsd,df->bsf', m, w_up[e])
        hid = jax.nn.silu(hu[..., :D_EXPERT]) * hu[..., D_EXPERT:]
        y = y + gate[..., e:e + 1] * jnp.einsum('bsf,fd->bsd', hid, w_down[e]).astype(jnp.float32)
    return y.astype(m.dtype)


def setup_inputs(seed: int = 0) -> dict:
    key = jax.random.key(seed)
    ks = jax.random.split(key, 24)
    f32 = jnp.float32

    def nrm(k, shape, fan_in):
        return jax.random.normal(k, shape, f32) * (fan_in ** -0.5)

    def gain(k, shape):
        return 1.0 + 0.1 * jax.random.normal(k, shape, f32)

    x = jax.random.normal(ks[0], (BATCH, SEQ, D_MODEL), f32)
    p = jax.random.normal(ks[1], (DEPTH, BATCH, SEQ, PLE_DIM), f32)
    offset = jax.random.randint(ks[2], (BATCH, 1), 0, 4096, dtype=jnp.int32)
    positions = (offset + jnp.arange(SEQ, dtype=jnp.int32)[None, :]).astype(jnp.int32)
    return {
        "x": x,
        "p": p,
        "positions": positions,
        "g_mix": gain(ks[3], (DEPTH, D_MODEL)),
        "w_in": nrm(ks[4], (DEPTH, D_MODEL, N_IN), D_MODEL),
        "b_f": FORGET_BIAS + 0.1 * jax.random.normal(ks[5], (DEPTH, N_HEADS_B), f32),
        "qn_a": gain(ks[6], (DEPTH, HEAD_DIM)),
        "kn_a": gain(ks[7], (DEPTH, HEAD_DIM)),
        "qn_b": gain(ks[8], (DEPTH, HEAD_DIM)),
        "kn_b": gain(ks[9], (DEPTH, HEAD_DIM)),
        "w_o": nrm(ks[10], (DEPTH, D_MIX, D_MODEL), D_MIX),
        "g_ffn": gain(ks[11], (DEPTH, D_MODEL)),
        "w_rg": nrm(ks[12], (DEPTH, D_MODEL, N_GROUPS), D_MODEL),
        "b_rg": 0.01 * jax.random.normal(ks[13], (DEPTH, N_GROUPS), f32),
        "w_re": nrm(ks[14], (DEPTH, N_GROUPS, D_MODEL, EXPERTS_PER_GROUP), D_MODEL),
        "b_re": 0.01 * jax.random.normal(ks[15], (DEPTH, N_GROUPS, EXPERTS_PER_GROUP), f32),
        "w_up": nrm(ks[16], (DEPTH, N_EXPERTS, D_MODEL, 2 * D_EXPERT), D_MODEL),
        "w_down": nrm(ks[17], (DEPTH, N_EXPERTS, D_EXPERT, D_MODEL), D_EXPERT),
        "g_ple": gain(ks[18], (DEPTH, D_MODEL)),
        "w_ple_gate": nrm(ks[19], (DEPTH, D_MODEL, D_MODEL), D_MODEL),
        "w_ple_proj": nrm(ks[20], (DEPTH, PLE_DIM, D_MODEL), PLE_DIM),
    }


def reference(x, p, positions, g_mix, w_in, b_f, qn_a, kn_a, qn_b, kn_b, w_o,
              g_ffn, w_rg, b_rg, w_re, b_re, w_up, w_down, g_ple, w_ple_gate, w_ple_proj):
    B, S, _ = x.shape
    cos, sin = rope_tables(positions)
    h = x
    for i in range(DEPTH):
        a = rmsnorm(h, g_mix[i])
        proj = jnp.einsum('bsd,dn->bsn', a, w_in[i])
        o0 = 0
        parts = []
        for (width, heads) in ((D_A, N_HEADS_A),) * 3 + ((D_B, N_HEADS_B),) * 3:
            parts.append(proj[..., o0:o0 + width].reshape(B, S, heads, HEAD_DIM))
            o0 += width
        qa, ka, va, qb, kb, vb = parts
        f_logit = proj[..., o0:o0 + N_HEADS_B]

        qa = partial_rope(rmsnorm(qa, qn_a[i]), cos, sin)
        ka = partial_rope(rmsnorm(ka, kn_a[i]), cos, sin)
        outs, lses = [], []
        for (window, dilation) in DILATED_PATTERNS:
            o_p, l_p = dilated_window_attention(qa, ka, va, window, dilation)
            outs.append(o_p)
            lses.append(l_p)
        alpha = jax.nn.softmax(jnp.stack(lses, axis=0), axis=0)
        oa = jnp.sum(alpha[..., None] * jnp.stack(outs, axis=0), axis=0)

        qb = rmsnorm(qb, qn_b[i])
        kb = rmsnorm(kb, kn_b[i])
        logf = jax.nn.log_sigmoid(f_logit.astype(jnp.float32) + b_f[i].astype(jnp.float32))
        ob = forgetting_attention(qb, kb, vb, logf)

        mix = jnp.concatenate([oa, ob], axis=2).reshape(B, S, D_MIX).astype(h.dtype)
        h = h + jnp.einsum('bsm,md->bsd', mix, w_o[i])

        h = h + hierarchical_moe(rmsnorm(h, g_ffn[i]), w_rg[i], b_rg[i], w_re[i], b_re[i],
                                 w_up[i], w_down[i])

        gate = jax.nn.sigmoid(jnp.einsum('bsd,de->bse', rmsnorm(h, g_ple[i]), w_ple_gate[i]).astype(jnp.float32))
        ple = jnp.einsum('bsc,cd->bsd', p[i], w_ple_proj[i]).astype(jnp.float32)
        h = h + (gate * ple).astype(h.dtype)
    return h
```

```cpp
#include <hip/hip_runtime.h>
#include <hip/hip_bf16.h>
#include <cstdio>
#include <cstdint>
#include <cmath>

__device__ __forceinline__ int tid_opaque() { int t = threadIdx.x; asm volatile("" : "+v"(t)); return t; }
namespace pg8 {
#define PG8_LAS __attribute__((address_space(3)))
typedef unsigned short bf16_t;
typedef short bf16x8 __attribute__((ext_vector_type(8)));
typedef float f32x4 __attribute__((ext_vector_type(4)));
typedef unsigned u32x4 __attribute__((ext_vector_type(4)));
typedef unsigned u32x2 __attribute__((ext_vector_type(2)));
constexpr int BM = 256, BK = 64, HALF = 128, HTB = HALF * BK * 2  , STAGE_BYTES = 8 * HTB, NXCD = 8, WGM = 8;

__host__ __device__ __forceinline__ int lds_byte(int r, int c) { const int st = (r >> 4) * 2 + (c >> 5), rr = r & 15, cc = c & 31, ob = rr * 64 + cc * 2; return st * 1024 + (ob ^ (((ob >> 9) & 1) << 5)); }
__host__ __device__ __forceinline__ void stage_rc(int b, int& R, int& C) { const int st = b / 1024, sb = b % 1024, swz = sb ^ (((sb >> 9) & 1) << 5); R = (st >> 1) * 16 + swz / 64; C = (st & 1) * 32 + (swz % 64) / 2; }
__host__ __device__ __forceinline__ int perm32(int rho) { const int n = rho >> 4, i = rho & 15; return 8 * (i >> 2) + 4 * n + (i & 3); }

struct Unit { int pm, pn, e, nrows, l0, kind; };

struct StaticOrder {
    int nM, nN, nwg, G, c;
    __host__ __device__ void init(int M, int N, int G_, int c_) { nM = M / BM; nN = N / BM; nwg = nM * nN; G = G_; c = c_; }
    __host__ __device__ bool next(int i, Unit& u) const {
        const long L = (long)i * G + c; if (L >= nwg) return false;
        int wgid = (int)L; { const int q = nwg / NXCD, r = nwg % NXCD, xcd = wgid % NXCD, off = wgid / NXCD; wgid = (xcd < r ? xcd * (q + 1) : r * (q + 1) + (xcd - r) * q) + off; }
        const int nig = WGM * nN, gid = wgid / nig, fm = gid * WGM, gsz = (nM - fm) < WGM ? (nM - fm) : WGM;
        u.pm = fm + ((wgid % nig) % gsz); u.pn = (wgid % nig) / gsz; u.e = 0; u.nrows = BM; u.l0 = 0; u.kind = 0; return true;
    }
};
__device__ __forceinline__ unsigned cvt_pk_bf16(float lo, float hi) { unsigned r; asm volatile("v_cvt_pk_bf16_f32 %0, %1, %2" : "=v"(r) : "v"(lo), "v"(hi)); return r; }

struct SrcDense {
    static constexpr bool VARIES = false;
    const bf16_t* A; const bf16_t* Bt; int K;
    __device__ __forceinline__ void setup(const Unit& u, const int (&Rr)[2], const int (&Cc)[2], const char*& aB, const char*& bB, unsigned (&vo)[2][2]) const {
        aB = (const char*)A + (size_t)u.pm * BM * K * 2; bB = (const char*)Bt + (size_t)u.pn * BM * K * 2;
#pragma unroll
        for (int h = 0; h < 2; ++h)
#pragma unroll
            for (int i = 0; i < 2; ++i) vo[h][i] = (unsigned)((h * HALF + Rr[i]) * K + Cc[i]) * 2u;
    }
};
template <class Epi, class Sched, class Src, bool ALIGN_EPI, bool SP2>
__device__ __forceinline__ void gemm_phase(PG8_LAS unsigned char* lds, const int K, const Sched& S, const Src& G, const Epi& E) {
    const int tid = tid_opaque(), wid = __builtin_amdgcn_readfirstlane(tid >> 6), lane = tid & 63, wr = wid >> 2, wc = wid & 3, fr = lane & 15, fq = lane >> 4;
    const int nt = K / BK;
    int Rr[2], Cc[2]; unsigned voffB[2];
#pragma unroll
    for (int i = 0; i < 2; ++i) { int R, C; stage_rc(tid * 16 + i * 8192, R, C); Rr[i] = R; Cc[i] = C; const int Rb = (R & ~31) + perm32(R & 31); voffB[i] = (unsigned)(Rb * K + C) * 2u; }
    const size_t kstep = (size_t)(BK * 2);
    const size_t hstep = (size_t)HALF * K * 2;
    const unsigned ldsw = (unsigned)wid * 1024u;
    const int aoff = lds_byte(wr * 64 + fr, fq * 8), boff = lds_byte(wc * 32 + fr, fq * 8);
#define PG8_SA(b, h) (((b) * 2 + (h)) * HTB)
#define PG8_SB(b, h) ((4 + (b) * 2 + (h)) * HTB)
#define PG8_STAGE(bufoff, gbase, voff) do { _Pragma("unroll") for (int _i = 0; _i < 2; ++_i) \
        __builtin_amdgcn_global_load_lds((const unsigned*)((const char*)(gbase) + (voff)[_i]), (PG8_LAS unsigned*)(lds + (bufoff) + ldsw + _i * 8192), 16, 0, 0); } while (0)
#define PG8_STA_C(bufoff, gbase, h) do { if constexpr (Src::VARIES) { PG8_STAGE(bufoff, gbase, vc[h]); } else { PG8_STAGE(bufoff, (gbase) + (h) * hstep, vc[0]); } } while (0)
#define PG8_STA_S(bufoff, gbase, h) do { if constexpr (Src::VARIES) { PG8_STAGE(bufoff, gbase, (h) ? s1 : s0); } else { PG8_STAGE(bufoff, (gbase) + (h) * hstep, vc[0]); } } while (0)
#define PG8_LDA(dst, b, h) do { _Pragma("unroll") for (int m = 0; m < 4; ++m) _Pragma("unroll") for (int k = 0; k < 2; ++k) dst[m][k] = *(const PG8_LAS bf16x8*)(lds + PG8_SA(b, h) + aoff + m * 2048 + k * 1024); } while (0)
#define PG8_LDB(dst, b, h) do { _Pragma("unroll") for (int n = 0; n < 2; ++n) _Pragma("unroll") for (int k = 0; k < 2; ++k) dst[n][k] = *(const PG8_LAS bf16x8*)(lds + PG8_SB(b, h) + boff + n * 2048 + k * 1024); } while (0)
#define PG8_MMA(ai, bj, At, Bt) do { __builtin_amdgcn_s_setprio(1); _Pragma("unroll") for (int m = 0; m < 4; ++m) _Pragma("unroll") for (int n = 0; n < 2; ++n) _Pragma("unroll") for (int k = 0; k < 2; ++k) \
        acc[ai][bj][m][n] = __builtin_amdgcn_mfma_f32_16x16x32_bf16(Bt[n][k], At[m][k], acc[ai][bj][m][n], 0, 0, 0); __builtin_amdgcn_s_setprio(0); } while (0)
#define PG8_WAIT_V(n) asm volatile("s_waitcnt vmcnt(" #n ")" ::: "memory")
#define PG8_WAIT_L(n) asm volatile("s_waitcnt lgkmcnt(" #n ")" ::: "memory")
#define PG8_BAR __builtin_amdgcn_s_barrier()
#define PG8_SCHED __builtin_amdgcn_sched_barrier(0)
    Unit cur, nxt; int ui = 0;
    if (!S.next(0, cur)) return;
    f32x4 acc[2][2][4][2];
#pragma unroll
    for (int a = 0; a < 2; ++a)
#pragma unroll
        for (int b = 0; b < 2; ++b)
#pragma unroll
            for (int m = 0; m < 4; ++m)
#pragma unroll
                for (int n = 0; n < 2; ++n) acc[a][b][m][n] = (f32x4){0.f, 0.f, 0.f, 0.f};
    bf16x8 At[4][2], B0[2][2], B1[2][2];
    const char *cA, *cB; unsigned vc[2][2];
    G.setup(cur, Rr, Cc, cA, cB, vc);
    if constexpr (SP2) {
        PG8_STAGE(PG8_SB(0, 0), cB, voffB); PG8_STAGE(PG8_SB(0, 1), cB + hstep, voffB); PG8_STA_C(PG8_SA(0, 0), cA, 0); PG8_STA_C(PG8_SA(0, 1), cA, 1);
        if (wr == 1) PG8_BAR;
        PG8_WAIT_V(2); PG8_BAR;
        PG8_STAGE(PG8_SB(1, 0), cB + kstep, voffB); PG8_STA_C(PG8_SA(1, 0), cA + kstep, 0); PG8_STAGE(PG8_SB(1, 1), cB + hstep + kstep, voffB);
        PG8_WAIT_V(6); PG8_BAR;
    } else {
        PG8_STAGE(PG8_SB(0, 0), cB, voffB); PG8_STA_C(PG8_SA(0, 0), cA, 0); PG8_STAGE(PG8_SB(0, 1), cB + hstep, voffB); PG8_STA_C(PG8_SA(0, 1), cA, 1);
        if (wr == 1) PG8_BAR;
        PG8_WAIT_V(4); PG8_BAR;
        PG8_STAGE(PG8_SB(1, 0), cB + kstep, voffB); PG8_STA_C(PG8_SA(1, 0), cA + kstep, 0); PG8_STAGE(PG8_SB(1, 1), cB + hstep + kstep, voffB);
        PG8_WAIT_V(6); PG8_BAR;
    }
    for (;;) {
        const bool has_next = S.next(ui + 1, nxt);
        const char *nA = cA, *nB = cB; unsigned vn[2][2] = {{vc[0][0], vc[0][1]}, {vc[1][0], vc[1][1]}};
        if (has_next) G.setup(nxt, Rr, Cc, nA, nB, vn);
        for (int t = 0; t < nt; t += 2) {
            const bool last = (t == nt - 2);
            const char* a1 = cA + (size_t)(t + 1) * kstep;
            const char* a2 = last ? nA : cA + (size_t)(t + 2) * kstep; const char* b2 = last ? nB : cB + (size_t)(t + 2) * kstep;
            const char* a3 = a2 + kstep; const char* b3 = b2 + kstep;
            const unsigned s0[2] = {last ? vn[0][0] : vc[0][0], last ? vn[0][1] : vc[0][1]}, s1[2] = {last ? vn[1][0] : vc[1][0], last ? vn[1][1] : vc[1][1]};
            if constexpr (SP2) {
            PG8_LDB(B0, 0, 0); PG8_LDB(B1, 0, 1); PG8_SCHED; PG8_LDA(At, 0, 0); PG8_STA_C(PG8_SA(1, 1), a1, 1);
            PG8_WAIT_V(8); PG8_WAIT_L(0); PG8_BAR; PG8_MMA(0, 0, At, B0); PG8_MMA(0, 1, At, B1); PG8_BAR; PG8_SCHED;
            PG8_LDA(At, 0, 1); PG8_STAGE(PG8_SB(0, 0), b2, voffB); PG8_STAGE(PG8_SB(0, 1), b2 + hstep, voffB); PG8_STA_S(PG8_SA(0, 0), a2, 0);
            PG8_WAIT_V(8); PG8_WAIT_L(0); PG8_BAR; PG8_MMA(1, 0, At, B0); PG8_MMA(1, 1, At, B1); PG8_BAR; PG8_SCHED;
            PG8_LDB(B0, 1, 0); PG8_LDB(B1, 1, 1); PG8_SCHED; PG8_LDA(At, 1, 0); PG8_STA_S(PG8_SA(0, 1), a2, 1);
            PG8_WAIT_V(8); PG8_WAIT_L(0); PG8_BAR; PG8_MMA(0, 0, At, B0); PG8_MMA(0, 1, At, B1); PG8_BAR; PG8_SCHED;
            PG8_LDA(At, 1, 1); PG8_STAGE(PG8_SB(1, 0), b3, voffB); PG8_STAGE(PG8_SB(1, 1), b3 + hstep, voffB); PG8_STA_S(PG8_SA(1, 0), a3, 0);
            PG8_WAIT_V(8); PG8_WAIT_L(0); PG8_BAR; PG8_MMA(1, 0, At, B0); PG8_MMA(1, 1, At, B1); PG8_BAR; PG8_SCHED;
            } else {
            PG8_LDB(B0, 0, 0); PG8_SCHED; PG8_LDA(At, 0, 0); PG8_STA_C(PG8_SA(1, 1), a1, 1);
            PG8_WAIT_L(8); PG8_BAR; PG8_WAIT_L(0); PG8_MMA(0, 0, At, B0); PG8_BAR; PG8_SCHED;
            PG8_LDB(B1, 0, 1); PG8_STAGE(PG8_SB(0, 0), b2, voffB);
            PG8_BAR; PG8_WAIT_L(0); PG8_MMA(0, 1, At, B1); PG8_BAR;
            PG8_LDA(At, 0, 1); PG8_STA_S(PG8_SA(0, 0), a2, 0);
            PG8_BAR; PG8_WAIT_L(0); PG8_MMA(1, 0, At, B0); PG8_BAR; PG8_SCHED;
            PG8_STAGE(PG8_SB(0, 1), b2 + hstep, voffB);
            PG8_WAIT_V(6); PG8_BAR; PG8_MMA(1, 1, At, B1); PG8_BAR;
            PG8_LDB(B0, 1, 0); PG8_SCHED; PG8_LDA(At, 1, 0); PG8_STA_S(PG8_SA(0, 1), a2, 1);
            PG8_WAIT_L(8); PG8_BAR; PG8_WAIT_L(0); PG8_MMA(0, 0, At, B0); PG8_BAR; PG8_SCHED;
            PG8_LDB(B1, 1, 1); PG8_STAGE(PG8_SB(1, 0), b3, voffB);
            PG8_BAR; PG8_WAIT_L(0); PG8_MMA(0, 1, At, B1); PG8_BAR;
            PG8_LDA(At, 1, 1); PG8_STA_S(PG8_SA(1, 0), a3, 0);
            PG8_BAR; PG8_WAIT_L(0); PG8_MMA(1, 0, At, B0); PG8_BAR; PG8_SCHED;
            PG8_STAGE(PG8_SB(1, 1), b3 + hstep, voffB);
            PG8_WAIT_V(6); PG8_BAR; PG8_MMA(1, 1, At, B1); PG8_BAR;
            }
        }
        if constexpr (ALIGN_EPI) { if (wr == 0) PG8_BAR; }
        { const int l2_ = tid_opaque() & 63; E(acc, cur, wr, wc, l2_ & 15, l2_ >> 4); }
        if (!has_next) break;
#pragma unroll
        for (int a = 0; a < 2; ++a)
#pragma unroll
            for (int b = 0; b < 2; ++b)
#pragma unroll
                for (int m = 0; m < 4; ++m)
#pragma unroll
                    for (int n = 0; n < 2; ++n) acc[a][b][m][n] = (f32x4){0.f, 0.f, 0.f, 0.f};
        cur = nxt; cA = nA; cB = nB; ++ui;
#pragma unroll
        for (int h = 0; h < 2; ++h)
#pragma unroll
            for (int i = 0; i < 2; ++i) vc[h][i] = vn[h][i];
        if constexpr (ALIGN_EPI) { if (wr == 1) PG8_BAR; }
    }
    PG8_WAIT_V(0);
    if constexpr (!ALIGN_EPI) { if (wr == 0) PG8_BAR; }
    PG8_BAR;
#undef PG8_SA
#undef PG8_SB
#undef PG8_STAGE
#undef PG8_STA_C
#undef PG8_STA_S
#undef PG8_LDA
#undef PG8_LDB
#undef PG8_MMA
#undef PG8_WAIT_V
#undef PG8_WAIT_L
#undef PG8_BAR
#undef PG8_SCHED
}

__device__ __forceinline__ float bf_lo(unsigned w) { return __uint_as_float(w << 16); }
__device__ __forceinline__ float bf_hi(unsigned w) { return __uint_as_float(w & 0xffff0000u); }
__device__ __forceinline__ u32x4 pack8(const f32x4 a, const f32x4 b) { u32x4 w; w.x = cvt_pk_bf16(a[0], a[1]); w.y = cvt_pk_bf16(a[2], a[3]); w.z = cvt_pk_bf16(b[0], b[1]); w.w = cvt_pk_bf16(b[2], b[3]); return w; }

__device__ __forceinline__ void store16_sc1(void* p, u32x4 v) { asm volatile("global_store_dwordx4 %0, %1, off sc1\n\ts_nop 1" :: "v"(p), "v"(v) : "memory"); }
struct EpiQKV {
    bf16_t* O; const float* gains; const float* rope; float c2;
    __device__ __forceinline__ void operator()(const f32x4 (&acc)[2][2][4][2], const Unit& u, int wr, int wc, int fr, int fq) const {
        const int kind = u.pn >> 1;
        const bool isv = (kind == 2) || (kind == 5), roped = kind < 2;
        const float* g = gains + (kind < 2 ? kind : (kind == 3 ? 2 : 3)) * 64;
        const float post = (kind == 0 || kind == 3) ? c2 : 1.f;
        f32x4 gv[2][2];
#pragma unroll
        for (int bj = 0; bj < 2; ++bj)
#pragma unroll
            for (int n = 0; n < 2; ++n) gv[bj][n] = isv ? (f32x4){1.f, 1.f, 1.f, 1.f} : *(const f32x4*)(g + 32 * bj + 8 * fq + 4 * n);
        const int row0 = u.pm * BM + wr * 64 + fr;
        bf16_t* colp = O + u.pn * 256 + wc * 64 + 8 * fq;
#pragma unroll
        for (int ai = 0; ai < 2; ++ai)
#pragma unroll
            for (int m = 0; m < 4; ++m) {
                const int row = row0 + ai * HALF + m * 16;
                f32x4 v[2][2];
#pragma unroll
                for (int bj = 0; bj < 2; ++bj)
#pragma unroll
                    for (int n = 0; n < 2; ++n) v[bj][n] = acc[ai][bj][m][n];
                if (!isv) {
                    float ss = 0.f;
#pragma unroll
                    for (int bj = 0; bj < 2; ++bj)
#pragma unroll
                        for (int n = 0; n < 2; ++n) { const f32x4 x = v[bj][n]; ss += (x[0] * x[0] + x[1] * x[1]) + (x[2] * x[2] + x[3] * x[3]); }
                    ss += __shfl_xor(ss, 16); ss += __shfl_xor(ss, 32);
                    const float r = 1.0f / sqrtf(ss * (1.0f / 64.0f) + 1e-6f);
#pragma unroll
                    for (int bj = 0; bj < 2; ++bj)
#pragma unroll
                        for (int n = 0; n < 2; ++n) v[bj][n] = v[bj][n] * r * gv[bj][n];
                    if (roped) {
#pragma unroll
                        for (int n = 0; n < 2; ++n) {
                            const f32x4 cs = *(const f32x4*)(rope + (size_t)row * 16 + 4 * n), sn = *(const f32x4*)(rope + (size_t)row * 16 + 8 + 4 * n);
                            const f32x4 mine = v[0][n]; f32x4 oth;
#pragma unroll
                            for (int i = 0; i < 4; ++i) oth[i] = __shfl_xor(mine[i], 16);
                            const f32x4 rot = (fq == 0) ? (mine * cs - oth * sn) : (mine * cs + oth * sn);
                            if (fq < 2) v[0][n] = rot;
                        }
                    }
#pragma unroll
                    for (int bj = 0; bj < 2; ++bj)
#pragma unroll
                        for (int n = 0; n < 2; ++n) v[bj][n] = v[bj][n] * post;
                }
#pragma unroll
                for (int bj = 0; bj < 2; ++bj) *(u32x4*)(colp + (size_t)row * 3072 + 32 * bj) = pack8(v[bj][0], v[bj][1]);
            }
    }
};
struct EpiBf16 {
    bf16_t* O; int ldc;
    __device__ __forceinline__ void operator()(const f32x4 (&acc)[2][2][4][2], const Unit& u, int wr, int wc, int fr, int fq) const {
        const int row0 = u.pm * BM + wr * 64 + fr, col0 = u.pn * BM + wc * 32 + 8 * fq;
#pragma unroll
        for (int ai = 0; ai < 2; ++ai)
#pragma unroll
            for (int m = 0; m < 4; ++m) { bf16_t* rowp = O + (size_t)(row0 + ai * HALF + m * 16) * ldc + col0;
#pragma unroll
                for (int bj = 0; bj < 2; ++bj) *(u32x4*)(rowp + bj * HALF) = pack8(acc[ai][bj][m][0], acc[ai][bj][m][1]); }
    }
};
struct EpiRes {
    const float* x; float* h1; bf16_t* hg; const float* g;
    __device__ __forceinline__ void operator()(const f32x4 (&acc)[2][2][4][2], const Unit& u, int wr, int wc, int fr, int fq) const {
        const int row0 = u.pm * BM + wr * 64 + fr, col0 = u.pn * BM + wc * 32 + 8 * fq;
        f32x4 gv[2][2];
#pragma unroll
        for (int bj = 0; bj < 2; ++bj)
#pragma unroll
            for (int n = 0; n < 2; ++n) gv[bj][n] = *(const f32x4*)(g + col0 + bj * HALF + 4 * n);
#pragma unroll
        for (int ai = 0; ai < 2; ++ai) {
            f32x4 xv[4][2][2];
#pragma unroll
            for (int m = 0; m < 4; ++m) { const size_t off = (size_t)(row0 + ai * HALF + m * 16) * 1024 + col0;
#pragma unroll
                for (int bj = 0; bj < 2; ++bj)
#pragma unroll
                    for (int n = 0; n < 2; ++n) xv[m][bj][n] = *(const f32x4*)(x + off + bj * HALF + 4 * n); }
#pragma unroll
            for (int m = 0; m < 4; ++m) { const size_t off = (size_t)(row0 + ai * HALF + m * 16) * 1024 + col0;
#pragma unroll
                for (int bj = 0; bj < 2; ++bj) {
                    const f32x4 h0 = xv[m][bj][0] + acc[ai][bj][m][0], h1v = xv[m][bj][1] + acc[ai][bj][m][1];
                    *(f32x4*)(h1 + off + bj * HALF) = h0; *(f32x4*)(h1 + off + bj * HALF + 4) = h1v;
                    *(u32x4*)(hg + off + bj * HALF) = pack8(h0 * gv[bj][0], h1v * gv[bj][1]); } }
            asm volatile("" ::: "memory"); }
    }
};
template <bool SC1> struct EpiSwigluT {
    bf16_t* hid; const float* listr; int T; const volatile PG8_LAS int* cnt;
    __device__ __forceinline__ void operator()(const f32x4 (&acc)[2][2][4][2], const Unit& u, int wr, int wc, int fr, int fq) const {
        const int last = __builtin_amdgcn_readfirstlane(cnt[u.e]) - 1;
#pragma unroll
        for (int ai = 0; ai < 2; ++ai)
#pragma unroll
            for (int m = 0; m < 4; ++m) {
                const int r = ai * HALF + wr * 64 + m * 16 + fr; int li = u.l0 + r; li = li < last ? li : last;
                const float rs = listr[(size_t)u.e * T + li];
                f32x4 hv[2];
#pragma unroll
                for (int n = 0; n < 2; ++n) { const f32x4 a = acc[ai][0][m][n] * rs, b = acc[ai][1][m][n] * rs;
#pragma unroll
                    for (int i = 0; i < 4; ++i) hv[n][i] = a[i] * __builtin_amdgcn_rcpf(1.0f + __builtin_amdgcn_exp2f(-1.4426950408889634f * a[i])) * b[i]; }
                bf16_t* dp = hid + (size_t)(u.pm * BM + r) * 512 + u.pn * 128 + wc * 32 + 8 * fq;
                if constexpr (SC1) store16_sc1(dp, pack8(hv[0], hv[1])); else *(u32x4*)dp = pack8(hv[0], hv[1]);
            }
    }
};
typedef EpiSwigluT<false> EpiSwiglu;
struct EpiDown {
    bf16_t* yb; const float* listw; int T; const volatile PG8_LAS int* cnt;
    __device__ __forceinline__ void operator()(const f32x4 (&acc)[2][2][4][2], const Unit& u, int wr, int wc, int fr, int fq) const {
        const int last = __builtin_amdgcn_readfirstlane(cnt[u.e]) - 1, col0 = u.pn * BM + wc * 32 + 8 * fq;
#pragma unroll
        for (int ai = 0; ai < 2; ++ai)
#pragma unroll
            for (int m = 0; m < 4; ++m) {
                const int r = ai * HALF + wr * 64 + m * 16 + fr; int li = u.l0 + r; li = li < last ? li : last;
                const float w = listw[(size_t)u.e * T + li];
                bf16_t* rowp = yb + (size_t)(u.pm * BM + r) * 1024 + col0;
#pragma unroll
                for (int bj = 0; bj < 2; ++bj) *(u32x4*)(rowp + bj * HALF) = pack8(acc[ai][bj][m][0] * w, acc[ai][bj][m][1] * w);
            }
    }
};
struct EpiFinal {
    float* out; const bf16_t* pleb; const bf16_t* h2b;
    __device__ __forceinline__ void operator()(const f32x4 (&acc)[2][2][4][2], const Unit& u, int wr, int wc, int fr, int fq) const {
        const int row0 = u.pm * BM + wr * 64 + fr, col0 = u.pn * BM + wc * 32 + 8 * fq;
#pragma unroll
        for (int ai = 0; ai < 2; ++ai)
#pragma unroll
          for (int mh = 0; mh < 2; ++mh) {
            u32x4 hw[2][2]; u32x4 pw[2][2];
#pragma unroll
            for (int mm = 0; mm < 2; ++mm) { const size_t off = (size_t)(row0 + ai * HALF + (2 * mh + mm) * 16) * 1024 + col0;
#pragma unroll
                for (int bj = 0; bj < 2; ++bj) { pw[mm][bj] = *(const u32x4*)(pleb + off + bj * HALF); hw[mm][bj] = *(const u32x4*)(h2b + off + bj * HALF); } }
#pragma unroll
            for (int mm = 0; mm < 2; ++mm) { const int m = 2 * mh + mm; const size_t off = (size_t)(row0 + ai * HALF + m * 16) * 1024 + col0;
#pragma unroll
                for (int bj = 0; bj < 2; ++bj) {
                    const u32x4 w = pw[mm][bj], hq = hw[mm][bj];
                    const f32x4 h0 = (f32x4){bf_lo(hq.x), bf_hi(hq.x), bf_lo(hq.y), bf_hi(hq.y)}, h1 = (f32x4){bf_lo(hq.z), bf_hi(hq.z), bf_lo(hq.w), bf_hi(hq.w)};
                    const f32x4 p0 = (f32x4){bf_lo(w.x), bf_hi(w.x), bf_lo(w.y), bf_hi(w.y)}, p1 = (f32x4){bf_lo(w.z), bf_hi(w.z), bf_lo(w.w), bf_hi(w.w)};
                    f32x4 g0, g1;
#pragma unroll
                    for (int i = 0; i < 4; ++i) { g0[i] = __builtin_amdgcn_rcpf(1.0f + __builtin_amdgcn_exp2f(-1.4426950408889634f * acc[ai][bj][m][0][i]));
                                                  g1[i] = __builtin_amdgcn_rcpf(1.0f + __builtin_amdgcn_exp2f(-1.4426950408889634f * acc[ai][bj][m][1][i])); }
                    *(f32x4*)(out + off + bj * HALF) = h0 + g0 * p0; *(f32x4*)(out + off + bj * HALF + 4) = h1 + g1 * p1; } }
            asm volatile("" ::: "memory"); }
    }
};
}

namespace pg8 {
struct MoeArgs { const bf16_t* HG; const bf16_t* Wup; bf16_t* HID; const bf16_t* Wdn; bf16_t* YB; const int* list; const float* listr; const float* listw;
                 unsigned* qctr; unsigned* done; unsigned* err; const volatile PG8_LAS int* tpre; const volatile PG8_LAS int* cnt; volatile PG8_LAS int* slot; int T, q0; };
__device__ __forceinline__ int moe_qlimit(const MoeArgs& M, int x) { return 8 * (M.tpre[4 * x + 4] - M.tpre[4 * x]); }
__device__ __forceinline__ int moe_fetch_sync(const MoeArgs& M, int& qx, int& tries) {
    while (tries < 8) {
        const int L = (int)__hip_atomic_fetch_add(M.qctr + 64 * qx, 1u, __ATOMIC_RELAXED, __HIP_MEMORY_SCOPE_AGENT);
        if (L < moe_qlimit(M, qx)) return (qx << 24) | L;
        qx = (qx + 1) & 7; ++tries;
    }
    return -1;
}
__device__ __forceinline__ void moe_decode(const MoeArgs& M, int gid, Unit& u) {
    const int x = gid >> 24, L = gid & 0xffffff, t0 = __builtin_amdgcn_readfirstlane(M.tpre[4 * x]), NU = 4 * (__builtin_amdgcn_readfirstlane(M.tpre[4 * x + 4]) - t0);
    u.kind = L >= NU ? 1 : 0; const int l = L - u.kind * NU, mt = t0 + (l >> 2); u.pn = l & 3; u.pm = mt;
    int e = 4 * x;
#pragma unroll
    for (int s = 1; s < 4; ++s) if (__builtin_amdgcn_readfirstlane(M.tpre[4 * x + s]) <= mt) e = 4 * x + s;
    u.e = e; u.l0 = (mt - __builtin_amdgcn_readfirstlane(M.tpre[e])) * BM; const int rem = __builtin_amdgcn_readfirstlane(M.cnt[e]) - u.l0; u.nrows = rem < BM ? rem : BM;
}
__device__ __forceinline__ void moe_setup(const MoeArgs& M, const Unit& u, int tid, const char*& aB, const char*& bB, unsigned (&vo)[2][2]) {
    int Rr[2], Cc[2];
#pragma unroll
    for (int i = 0; i < 2; ++i) stage_rc(tid * 16 + i * 8192, Rr[i], Cc[i]);
    if (u.kind == 0) {
        aB = (const char*)M.HG; bB = (const char*)M.Wup + ((size_t)u.e * 1024 + (size_t)u.pn * BM) * 1024 * 2;
        const int last = __builtin_amdgcn_readfirstlane(M.cnt[u.e]) - 1;
#pragma unroll
        for (int h = 0; h < 2; ++h)
#pragma unroll
            for (int i = 0; i < 2; ++i) { int li = u.l0 + h * HALF + Rr[i]; li = li < last ? li : last; const int tok = M.list[(size_t)u.e * M.T + li] >> 1; vo[h][i] = (unsigned)(tok * 1024 + Cc[i]) * 2u; }
    } else {
        aB = (const char*)M.HID + (size_t)u.pm * BM * 512 * 2; bB = (const char*)M.Wdn + ((size_t)u.e * 1024 + (size_t)u.pn * BM) * 512 * 2;
#pragma unroll
        for (int h = 0; h < 2; ++h)
#pragma unroll
            for (int i = 0; i < 2; ++i) vo[h][i] = (unsigned)((h * HALF + Rr[i]) * 512 + Cc[i]) * 2u;
    }
}
__device__ __forceinline__ void moe_wait_ready(const MoeArgs& M, const Unit& u) {
    if (u.kind == 1) {
        unsigned sp = 0;
        while (__hip_atomic_load(M.done + u.pm, __ATOMIC_RELAXED, __HIP_MEMORY_SCOPE_AGENT) < 4u) { __builtin_amdgcn_s_sleep(2); if (++sp > (1u << 22)) { __hip_atomic_store(M.err, 1u, __ATOMIC_RELAXED, __HIP_MEMORY_SCOPE_AGENT); break; } }
        asm volatile("" ::: "memory");
    }
}
__device__ __forceinline__ void moe_phase(PG8_LAS unsigned char* lds, const MoeArgs& M) {
    const int tid = tid_opaque(), wid = __builtin_amdgcn_readfirstlane(tid >> 6), lane = tid & 63, wr = wid >> 2, wc = wid & 3, fr = lane & 15, fq = lane >> 4;
    unsigned vB1k[2];
#pragma unroll
    for (int i = 0; i < 2; ++i) { int R, C; stage_rc(tid * 16 + i * 8192, R, C); const int Rb = (R & ~31) + perm32(R & 31); vB1k[i] = (unsigned)(Rb * 1024 + C) * 2u; }
#define VB512(i) ((vB1k[i] >> 1) + ((vB1k[i] & 2047u) >> 1))
    const size_t kstep = (size_t)(BK * 2);
    const unsigned ldsw = (unsigned)wid * 1024u;
    const int aoff = lds_byte(wr * 64 + fr, fq * 8), boff = lds_byte(wc * 32 + fr, fq * 8);
#define PG8_SA(b, h) (((b) * 2 + (h)) * HTB)
#define PG8_SB(b, h) ((4 + (b) * 2 + (h)) * HTB)
#define PG8_STAGE(bufoff, gbase, voff) do { _Pragma("unroll") for (int _i = 0; _i < 2; ++_i) \
        __builtin_amdgcn_global_load_lds((const unsigned*)((const char*)(gbase) + (voff)[_i]), (PG8_LAS unsigned*)(lds + (bufoff) + ldsw + _i * 8192), 16, 0, 0); } while (0)
#define PG8_LDA(dst, b, h) do { _Pragma("unroll") for (int m = 0; m < 4; ++m) _Pragma("unroll") for (int k = 0; k < 2; ++k) dst[m][k] = *(const PG8_LAS bf16x8*)(lds + PG8_SA(b, h) + aoff + m * 2048 + k * 1024); } while (0)
#define PG8_LDB(dst, b, h) do { _Pragma("unroll") for (int n = 0; n < 2; ++n) _Pragma("unroll") for (int k = 0; k < 2; ++k) dst[n][k] = *(const PG8_LAS bf16x8*)(lds + PG8_SB(b, h) + boff + n * 2048 + k * 1024); } while (0)
#define PG8_MMA(ai, bj, At, Bt) do { __builtin_amdgcn_s_setprio(1); _Pragma("unroll") for (int m = 0; m < 4; ++m) _Pragma("unroll") for (int n = 0; n < 2; ++n) _Pragma("unroll") for (int k = 0; k < 2; ++k) \
        acc[ai][bj][m][n] = __builtin_amdgcn_mfma_f32_16x16x32_bf16(Bt[n][k], At[m][k], acc[ai][bj][m][n], 0, 0, 0); __builtin_amdgcn_s_setprio(0); } while (0)
#define PG8_WAIT_V(n) asm volatile("s_waitcnt vmcnt(" #n ")" ::: "memory")
#define PG8_WAIT_L(n) asm volatile("s_waitcnt lgkmcnt(" #n ")" ::: "memory")
#define PG8_BAR __builtin_amdgcn_s_barrier()
#define PG8_SCHED __builtin_amdgcn_sched_barrier(0)
    Unit cur, nxt; int ui = 0;
    int qx = M.q0, tries = 0;
    if (tid == 0) { M.slot[0] = moe_fetch_sync(M, qx, tries); M.slot[1] = moe_fetch_sync(M, qx, tries); }
    asm volatile("s_waitcnt lgkmcnt(0)\n\ts_barrier" ::: "memory");
    { const int g0 = __builtin_amdgcn_readfirstlane(M.slot[0]); if (g0 < 0) return; moe_decode(M, g0, cur); }
    f32x4 acc[2][2][4][2];
#pragma unroll
    for (int a = 0; a < 2; ++a)
#pragma unroll
        for (int b = 0; b < 2; ++b)
#pragma unroll
            for (int m = 0; m < 4; ++m)
#pragma unroll
                for (int n = 0; n < 2; ++n) acc[a][b][m][n] = (f32x4){0.f, 0.f, 0.f, 0.f};
    bf16x8 At[4][2], B0[2][2], B1[2][2];
    const char *cA, *cB; unsigned vc[2][2];
    for (;;) {
    moe_wait_ready(M, cur);
    moe_setup(M, cur, tid, cA, cB, vc);
    {   const size_t hs = cur.kind ? (size_t)HALF * 512 * 2 : (size_t)HALF * 1024 * 2; const unsigned vb[2] = {cur.kind ? VB512(0) : vB1k[0], cur.kind ? VB512(1) : vB1k[1]};
        PG8_STAGE(PG8_SB(0, 0), cB, vb); PG8_STAGE(PG8_SB(0, 1), cB + hs, vb); PG8_STAGE(PG8_SA(0, 0), cA, vc[0]); PG8_STAGE(PG8_SA(0, 1), cA, vc[1]);
        if (wr == 1) PG8_BAR;
        PG8_WAIT_V(2); PG8_BAR;
        PG8_STAGE(PG8_SB(1, 0), cB + kstep, vb); PG8_STAGE(PG8_SA(1, 0), cA + kstep, vc[0]); PG8_STAGE(PG8_SB(1, 1), cB + hs + kstep, vb);
        PG8_WAIT_V(6); PG8_BAR; }
    bool stop = false;
    for (;;) {
        const int gnx = __builtin_amdgcn_readfirstlane(M.slot[(ui + 1) & 1]); const bool has_next = gnx >= 0;
        if (has_next) moe_decode(M, gnx, nxt);
        int pend = 0x7fffffff;
        if (tid == 0 && tries < 8) pend = (int)__hip_atomic_fetch_add(M.qctr + 64 * qx, 1u, __ATOMIC_RELAXED, __HIP_MEMORY_SCOPE_AGENT);
        const char *nA = cA, *nB = cB; unsigned vn[2][2] = {{vc[0][0], vc[0][1]}, {vc[1][0], vc[1][1]}};
        if (has_next) moe_setup(M, nxt, tid, nA, nB, vn);
        const int nt = cur.kind ? 8 : 16;
        const size_t hsC = cur.kind ? (size_t)HALF * 512 * 2 : (size_t)HALF * 1024 * 2;
        bool chain = has_next;
        for (int t = 0; t < nt; t += 2) {
            const bool last = (t == nt - 2);
            if (t == nt - 4 && has_next && nxt.kind == 1 && tid == 0) M.slot[2] = (__hip_atomic_load(M.done + nxt.pm, __ATOMIC_RELAXED, __HIP_MEMORY_SCOPE_AGENT) >= 4u) ? 1 : 0;
            if (last && has_next && nxt.kind == 1) {
                if (__builtin_amdgcn_readfirstlane(M.slot[2]) == 0) { if (cur.kind == 1) moe_wait_ready(M, nxt); else chain = false; }
            }
            const int nk = chain ? nxt.kind : cur.kind;
            const size_t hsN = nk ? (size_t)HALF * 512 * 2 : (size_t)HALF * 1024 * 2;
            const bool usen = last && chain;
            const char* a1 = cA + (size_t)(t + 1) * kstep;
            const char* a2 = usen ? nA : (last ? cA : cA + (size_t)(t + 2) * kstep); const char* b2 = usen ? nB : (last ? cB : cB + (size_t)(t + 2) * kstep);
            const char* a3 = a2 + kstep; const char* b3 = b2 + kstep;
            const unsigned s0[2] = {usen ? vn[0][0] : vc[0][0], usen ? vn[0][1] : vc[0][1]}, s1[2] = {usen ? vn[1][0] : vc[1][0], usen ? vn[1][1] : vc[1][1]};
            const int k2 = last ? nk : cur.kind; const size_t hs2 = last ? hsN : hsC;
            const unsigned vb2[2] = {k2 ? VB512(0) : vB1k[0], k2 ? VB512(1) : vB1k[1]};
            PG8_LDB(B0, 0, 0); PG8_LDB(B1, 0, 1); PG8_SCHED; PG8_LDA(At, 0, 0); PG8_STAGE(PG8_SA(1, 1), a1, vc[1]);
            PG8_WAIT_V(8); PG8_WAIT_L(0); PG8_BAR; PG8_MMA(0, 0, At, B0); PG8_MMA(0, 1, At, B1); PG8_BAR; PG8_SCHED;
            PG8_LDA(At, 0, 1); PG8_STAGE(PG8_SB(0, 0), b2, vb2); PG8_STAGE(PG8_SB(0, 1), b2 + hs2, vb2); PG8_STAGE(PG8_SA(0, 0), a2, s0);
            PG8_WAIT_V(8); PG8_WAIT_L(0); PG8_BAR; PG8_MMA(1, 0, At, B0); PG8_MMA(1, 1, At, B1); PG8_BAR; PG8_SCHED;
            PG8_LDB(B0, 1, 0); PG8_LDB(B1, 1, 1); PG8_SCHED; PG8_LDA(At, 1, 0); PG8_STAGE(PG8_SA(0, 1), a2, s1);
            PG8_WAIT_V(8); PG8_WAIT_L(0); PG8_BAR; PG8_MMA(0, 0, At, B0); PG8_MMA(0, 1, At, B1); PG8_BAR; PG8_SCHED;
            PG8_LDA(At, 1, 1); PG8_STAGE(PG8_SB(1, 0), b3, vb2); PG8_STAGE(PG8_SB(1, 1), b3 + hs2, vb2); PG8_STAGE(PG8_SA(1, 0), a3, s0);
            PG8_WAIT_V(8); PG8_WAIT_L(0); PG8_BAR; PG8_MMA(1, 0, At, B0); PG8_MMA(1, 1, At, B1); PG8_BAR; PG8_SCHED;
        }
        if (wr == 0) PG8_BAR;
        if (cur.kind == 0) {
            EpiSwigluT<true> E{M.HID, M.listr, M.T, M.cnt}; { const int l2_ = tid_opaque() & 63; E(acc, cur, wr, wc, l2_ & 15, l2_ >> 4); }
            asm volatile("s_waitcnt vmcnt(0)" ::: "memory");
        } else {
            EpiDown E{M.YB, M.listw, M.T, M.cnt}; { const int l2_ = tid_opaque() & 63; E(acc, cur, wr, wc, l2_ & 15, l2_ >> 4); }
        }
        if (tid == 0) {
            int g2 = -1;
            if (tries < 8) { if (pend < moe_qlimit(M, qx)) g2 = (qx << 24) | pend; else { qx = (qx + 1) & 7; ++tries; g2 = moe_fetch_sync(M, qx, tries); } }
            M.slot[ui & 1] = g2;
        }
        asm volatile("s_waitcnt lgkmcnt(0)" ::: "memory");
        PG8_BAR;
        if (cur.kind == 0 && tid == 0) __hip_atomic_fetch_add(M.done + cur.pm, 1u, __ATOMIC_RELAXED, __HIP_MEMORY_SCOPE_AGENT);
        if (!has_next) { stop = true; break; }
#pragma unroll
        for (int a = 0; a < 2; ++a)
#pragma unroll
            for (int b = 0; b < 2; ++b)
#pragma unroll
                for (int m = 0; m < 4; ++m)
#pragma unroll
                    for (int n = 0; n < 2; ++n) acc[a][b][m][n] = (f32x4){0.f, 0.f, 0.f, 0.f};
        cur = nxt; ++ui;
        if (!chain) break;
        cA = nA; cB = nB;
#pragma unroll
        for (int h = 0; h < 2; ++h)
#pragma unroll
            for (int i = 0; i < 2; ++i) vc[h][i] = vn[h][i];
        if (wr == 1) PG8_BAR;
    }
    PG8_WAIT_V(0);
    PG8_BAR;
    if (stop) break;
    }
#undef VB512
#undef PG8_SA
#undef PG8_SB
#undef PG8_STAGE
#undef PG8_LDA
#undef PG8_LDB
#undef PG8_MMA
#undef PG8_WAIT_V
#undef PG8_WAIT_L
#undef PG8_BAR
#undef PG8_SCHED
}
}

namespace attn_body {
using bf16=__hip_bfloat16;
using bf16x8=__attribute__((ext_vector_type(8)))short;
using s16x4=__attribute__((ext_vector_type(4)))short;
using f32x16=__attribute__((ext_vector_type(16)))float;
using f32x4=__attribute__((ext_vector_type(4)))float;
using u32x4=__attribute__((ext_vector_type(4)))unsigned;
constexpr int BATCH=8,NHEAD=8,SEQ=2048,D=64,DMQ=3072,DMO=1024;
constexpr int NW=8,QBLK=32,QB=QBLK*NW,KVBLK=64,NQB=SEQ/QB;
__device__ __forceinline__ int crow(int r,int hi){return (r&3)+8*(r>>2)+4*hi;}
#define SBAR() __builtin_amdgcn_sched_barrier(0)
__device__ __forceinline__ void cmask(f32x16&p0,f32x16&p1,int jb,int qrel,int hi){
  const float NEG=-INFINITY; const int d=qrel-64*jb-4*hi;
  #pragma unroll
  for(int r=0;r<16;++r){const int k=(r&3)+8*(r>>2); if(k>d)p0[r]=NEG; if(k+32>d)p1[r]=NEG;}
}
constexpr int NSLOT=3, SLOTB=8192;
constexpr int LDS_K=0, LDS_V=NSLOT*SLOTB, LDS_WS=2*NSLOT*SLOTB, LDS_OST=LDS_WS+NW*64*4, LDS_BIAS=LDS_OST+NW*4096, LUT_OFF=256, LUT_N=SEQ+LUT_OFF, LDS_LUT=LDS_BIAS+SEQ*4, LDS_BYTES=LDS_LUT+LUT_N*4;
__device__ __forceinline__ void glds16(const void*gsrc,unsigned lds_dst){unsigned keep;
  asm volatile("s_mov_b32 %0, m0\n\ts_mov_b32 m0, %2\n\ts_nop 0\n\tglobal_load_lds_dwordx4 %1, off\n\ts_mov_b32 m0, %0":"=&s"(keep):"v"(gsrc),"s"(lds_dst):"memory");}
typedef float f32x2_t __attribute__((ext_vector_type(2))); typedef __bf16 bf16x2_t __attribute__((ext_vector_type(2)));
__device__ __forceinline__ unsigned cvtpk_s(float lo,float hi){f32x2_t v={lo,hi};bf16x2_t b=__builtin_convertvector(v,bf16x2_t);return __builtin_bit_cast(unsigned,b);}
#define WAIT_BAR(N) asm volatile("s_waitcnt vmcnt(" #N ") lgkmcnt(0)\n\ts_barrier":::"memory")
typedef __attribute__((address_space(3))) const char* lds_cptr;
typedef short v4i16_t __attribute__((ext_vector_type(4)));
__device__ __forceinline__ void kload8(bf16x8*kf,lds_cptr kp){
  kf[0]=*(const __attribute__((address_space(3))) bf16x8*)(kp);      kf[1]=*(const __attribute__((address_space(3))) bf16x8*)(kp+512);
  kf[2]=*(const __attribute__((address_space(3))) bf16x8*)(kp+2048); kf[3]=*(const __attribute__((address_space(3))) bf16x8*)(kp+2560);
  kf[4]=*(const __attribute__((address_space(3))) bf16x8*)(kp+4096); kf[5]=*(const __attribute__((address_space(3))) bf16x8*)(kp+4608);
  kf[6]=*(const __attribute__((address_space(3))) bf16x8*)(kp+6144); kf[7]=*(const __attribute__((address_space(3))) bf16x8*)(kp+6656);
}
__device__ __forceinline__ void kload2(bf16x8*kf,lds_cptr kp,int j){ kf[2*j]=*(const __attribute__((address_space(3))) bf16x8*)(kp+j*2048); kf[2*j+1]=*(const __attribute__((address_space(3))) bf16x8*)(kp+j*2048+512); }
__device__ __forceinline__ s16x4 vtr(lds_cptr p){ return __builtin_bit_cast(s16x4,__builtin_amdgcn_ds_read_tr16_b64_v4i16((__attribute__((address_space(3))) v4i16_t*)p)); }
__device__ __forceinline__ void pv(f32x16*o,int vb,bf16x8 pa0,bf16x8 pa1,bf16x8 pa2,bf16x8 pa3){
  #pragma unroll
  for(int d0=0;d0<2;++d0){s16x4 lo[4],hi[4];
    #pragma unroll
    for(int ks=0;ks<4;++ks){
      asm volatile("ds_read_b64_tr_b16 %0,%1 offset:%c2":"=&v"(lo[ks]):"v"(vb),"i"(d0*4096+ks*1024):"memory");
      asm volatile("ds_read_b64_tr_b16 %0,%1 offset:%c2":"=&v"(hi[ks]):"v"(vb),"i"(d0*4096+ks*1024+512):"memory");}
    asm volatile("s_waitcnt lgkmcnt(0)":::"memory");SBAR();
    #define PK(k) (bf16x8){lo[k][0],lo[k][1],lo[k][2],lo[k][3],hi[k][0],hi[k][1],hi[k][2],hi[k][3]}
    o[d0]=__builtin_amdgcn_mfma_f32_32x32x16_bf16(pa0,PK(0),o[d0],0,0,0);
    o[d0]=__builtin_amdgcn_mfma_f32_32x32x16_bf16(pa1,PK(1),o[d0],0,0,0);
    o[d0]=__builtin_amdgcn_mfma_f32_32x32x16_bf16(pa2,PK(2),o[d0],0,0,0);
    o[d0]=__builtin_amdgcn_mfma_f32_32x32x16_bf16(pa3,PK(3),o[d0],0,0,0);
    #undef PK
  }
}
template<int KIND> __device__ __forceinline__ void bias_tile(f32x16&c0,f32x16&c1,const __attribute__((address_space(3))) float*bl,int t,float cq,int dq,int hi){
  if constexpr(KIND==0){
    const __attribute__((address_space(3))) float*p=bl+64*t+4*hi;
    #pragma unroll
    for(int g=0;g<4;++g){ const f32x4 a=*(const __attribute__((address_space(3))) f32x4*)(p+8*g), b=*(const __attribute__((address_space(3))) f32x4*)(p+32+8*g);
      #pragma unroll
      for(int j=0;j<4;++j){c0[4*g+j]=cq-a[j];c1[4*g+j]=cq-b[j];} }
  } else {
    const __attribute__((address_space(3))) float*p=bl+(dq-64*t-4*hi);
    #pragma unroll
    for(int r=0;r<16;++r){ const int k=(r&3)+8*(r>>2); c0[r]=p[-k]; c1[r]=p[-k-32]; }
  }
}

__device__ __forceinline__ void next_ptrs(int kind,int b,int h,int qb,const bf16*QKV,const bf16*&nQ,const bf16*&nK){
  const int tid=tid_opaque(),lane=tid&63,r32=lane&31,hi=lane>>5; const int wid=__builtin_amdgcn_readfirstlane(tid>>6);
  const int QC=(kind==0)?1536:0, KC=QC+512; const long rowbase=(long)b*SEQ;
  nQ=QKV+(rowbase+qb*QB+wid*QBLK+r32)*DMQ+QC+h*D+hi*8;
  nK=QKV+(rowbase+lane)*DMQ+KC+h*D+wid*8;
}
template<int KIND> __device__ __forceinline__ void attn_unit(int b,int h,int qb,const bf16*QKV,const float*__restrict__ cumg,bf16*MIX,char*shm,const bool pre,bf16x8(&qio)[4],const bf16*nQ,const bf16*nK){
  const int tid=tid_opaque(),lane=tid&63,r32=lane&31,hi=lane>>5; const int wid=__builtin_amdgcn_readfirstlane(tid>>6);
  const long rowbase=(long)b*SEQ; const int q0=qb*QB;
  constexpr int QC=(KIND==0)?1536:0, KC=QC+512, VC=QC+1024, OC=(KIND==0)?512:0;
  const bf16*Qw=QKV+(rowbase+q0+wid*QBLK)*DMQ+QC+h*D;
  const bf16*Kh=QKV+rowbase*DMQ+KC+h*D,*Vh=QKV+rowbase*DMQ+VC+h*D;
  const unsigned lds0=(unsigned)(uintptr_t)shm;
  float*wsf=(float*)(shm+LDS_WS)+wid*64;
  const __attribute__((address_space(3))) float*bl=(const __attribute__((address_space(3))) float*)((lds_cptr)shm+((KIND==0)?LDS_BIAS:LDS_LUT));
  float cq=0.f; const int dq=q0+wid*QBLK+r32+LUT_OFF;
  if constexpr(KIND==0){
    const float*cg=cumg+((long)b*NHEAD+h)*SEQ;
    __attribute__((address_space(3))) float*bw=(__attribute__((address_space(3))) float*)((__attribute__((address_space(3))) char*)shm+LDS_BIAS);
    for(int i=tid;i<q0+QB;i+=NW*64)bw[i]=cg[i];
    cq=cg[q0+wid*QBLK+r32];
  }
  const bf16*ksrc=Kh+(long)lane*DMQ+wid*8;
  const bf16*vsrc=Vh+(long)(16*(wid&3)+(lane>>2))*DMQ+(wid>>2)*32+(lane&3)*8;
  const unsigned kdst=lds0+LDS_K+wid*1024, vdst=lds0+LDS_V+wid*1024;
  #define DMA_K(t,slot) glds16(ksrc+(long)(t)*KVBLK*DMQ,(unsigned)__builtin_amdgcn_readfirstlane(kdst+(slot)))
  #define DMA_V(t,slot) glds16(vsrc+(long)(t)*KVBLK*DMQ,(unsigned)__builtin_amdgcn_readfirstlane(vdst+(slot)))
  const int vb0=(int)(lds0+LDS_V)+((lane>>4)&1)*32+(lane&3)*8+(4*hi+((lane&15)>>2))*64;
  bf16x8 kf[8];
  const lds_cptr shm3=(lds_cptr)shm; const lds_cptr kp0=shm3+LDS_K+hi*1024+r32*16; const lds_cptr vp0=shm3+LDS_V+((lane>>4)&1)*32+(lane&3)*8+(4*hi+((lane&15)>>2))*64;
  const int NT=(q0+QB)/KVBLK;
  bf16x8 qr[4];
  if(pre){ DMA_V(0,0);
    #pragma unroll
    for(int d0=0;d0<4;++d0)qr[d0]=qio[d0];
  } else { DMA_K(0,0);DMA_V(0,0);DMA_K(1,SLOTB);
    #pragma unroll
    for(int d0=0;d0<4;++d0)qr[d0]=*reinterpret_cast<const bf16x8*>(&Qw[(long)r32*DMQ+d0*16+hi*8]); }
  float l_reg=0.f;f32x16 o[2];o[0]=f32x16{};o[1]=f32x16{};
  const int qrel=wid*QBLK+r32;
  #define CMASK(P0,P1,t) do{int jb_=(t)-(NT-4); if(jb_>=0)cmask(P0,P1,jb_,qrel,hi);}while(0)
  f32x16 pA0,pA1,pB0,pB1;
  int sl_prev=0,sl_cur=0,sl_next=SLOTB;
  #define ROT() do{sl_prev=sl_cur;sl_cur=sl_next;sl_next=(sl_next==(NSLOT-1)*SLOTB)?0:sl_next+SLOTB;}while(0)
  if(pre){ WAIT_BAR(1); }
  else { DMA_K(2,2*SLOTB);
  WAIT_BAR(3); }
  { f32x16 c0,c1; bias_tile<KIND>(c0,c1,bl,0,cq,dq,hi);
    const lds_cptr kb=kp0;
    #pragma unroll
    for(int d0=0;d0<4;++d0){
      const bf16x8 b0=*(const __attribute__((address_space(3))) bf16x8*)(kb+d0*2048);
      const bf16x8 b1=*(const __attribute__((address_space(3))) bf16x8*)(kb+d0*2048+512);
      if(d0==0){pA0=__builtin_amdgcn_mfma_f32_32x32x16_bf16(b0,qr[0],c0,0,0,0);pA1=__builtin_amdgcn_mfma_f32_32x32x16_bf16(b1,qr[0],c1,0,0,0);}
      else{pA0=__builtin_amdgcn_mfma_f32_32x32x16_bf16(b0,qr[d0],pA0,0,0,0);pA1=__builtin_amdgcn_mfma_f32_32x32x16_bf16(b1,qr[d0],pA1,0,0,0);}}
  }
  CMASK(pA0,pA1,0);
  _Pragma("unroll") for(int r=0;r<16;++r){pA0[r]=__builtin_amdgcn_exp2f(pA0[r]);pA1[r]=__builtin_amdgcn_exp2f(pA1[r]);}
  WAIT_BAR(0);
  DMA_K(3,0);DMA_V(1,SLOTB);
  ROT();
  kload8(kf,kp0+sl_cur);
  WAIT_BAR(2);
  s16x4 vlo[8],vhi[8]; u32x4 pw0,pw1,pw2,pw3;
  #define PKW(P,B) cvtpk_s(P[B],P[B+1])
  #define PAF(k) __builtin_bit_cast(bf16x8,pw##k)
  #define VFR(i) (bf16x8){vlo[i][0],vlo[i][1],vlo[i][2],vlo[i][3],vhi[i][0],vhi[i][1],vhi[i][2],vhi[i][3]}
  #define PIN(x) asm volatile("":"+v"(x))
  #define GAPA(MF,A0,A1,A2,A3,W0,W1,PW) do{ MF; sacc+=A0; sacc+=A1; sacc+=A2; sacc+=A3; PIN(sacc); W0; W1; PIN(PW); SBAR(); }while(0)
  #define EX(v) __builtin_amdgcn_exp2f(v)
  #define GAPB(MF,X,B) do{ MF; X[B]=EX(X[B]); X[B+1]=EX(X[B+1]); X[B+2]=EX(X[B+2]); X[B+3]=EX(X[B+3]); PIN(X); SBAR(); }while(0)
  #define VRD(i) do{ vlo[i]=vtr(vp_+(((i)>>2)*4096+((i)&3)*1024)); vhi[i]=vtr(vp_+(((i)>>2)*4096+((i)&3)*1024+512)); }while(0)
  #define KRD(G,j) do{ if(G){ kload2(kf,kp0+sl_next,j); SBAR(); } }while(0)
  #define STEP(C0,C1,P0,P1,t,GK,GV,GL) do{ SBAR(); \
    bias_tile<KIND>(C0,C1,bl,(t),cq,dq,hi); SBAR(); \
    const lds_cptr vp_=vp0+sl_prev; \
    VRD(0); SBAR(); float sacc=(P0[0]+P0[1]); \
    GAPA(C0=__builtin_amdgcn_mfma_f32_32x32x16_bf16(kf[0],qr[0],C0,0,0,0), P0[2],P0[3],P0[4],P0[5],     pw0[0]=PKW(P0,0), pw0[1]=PKW(P0,2), pw0); \
    VRD(4); SBAR(); GAPA(C1=__builtin_amdgcn_mfma_f32_32x32x16_bf16(kf[1],qr[0],C1,0,0,0), P0[6],P0[7],P0[8],P0[9],     pw0[2]=PKW(P0,4), pw0[3]=PKW(P0,6), pw0); \
    VRD(1); SBAR(); GAPA(C0=__builtin_amdgcn_mfma_f32_32x32x16_bf16(kf[2],qr[1],C0,0,0,0),   P0[10],P0[11],P0[12],P0[13], pw1[0]=PKW(P0,8), pw1[1]=PKW(P0,10), pw1); \
    VRD(5); SBAR(); GAPA(C1=__builtin_amdgcn_mfma_f32_32x32x16_bf16(kf[3],qr[1],C1,0,0,0),   P0[14],P0[15],P1[0],P1[1],   pw1[2]=PKW(P0,12),pw1[3]=PKW(P0,14), pw1); \
    VRD(2); SBAR(); GAPA(C0=__builtin_amdgcn_mfma_f32_32x32x16_bf16(kf[4],qr[2],C0,0,0,0),   P1[2],P1[3],P1[4],P1[5],     pw2[0]=PKW(P1,0), pw2[1]=PKW(P1,2), pw2); \
    VRD(6); SBAR(); GAPA(C1=__builtin_amdgcn_mfma_f32_32x32x16_bf16(kf[5],qr[2],C1,0,0,0),   P1[6],P1[7],P1[8],P1[9],     pw2[2]=PKW(P1,4), pw2[3]=PKW(P1,6), pw2); \
    VRD(3); SBAR(); GAPA(C0=__builtin_amdgcn_mfma_f32_32x32x16_bf16(kf[6],qr[3],C0,0,0,0),   P1[10],P1[11],P1[12],P1[13], pw3[0]=PKW(P1,8), pw3[1]=PKW(P1,10), pw3); \
    VRD(7); SBAR(); GAPA(C1=__builtin_amdgcn_mfma_f32_32x32x16_bf16(kf[7],qr[3],C1,0,0,0),   P1[14],P1[15],0.f,0.f,       pw3[2]=PKW(P1,12),pw3[3]=PKW(P1,14), pw3); \
    l_reg+=sacc; \
    if(GK){DMA_K((t)+3,sl_cur);} if(GV){DMA_V((t)+1,sl_next);} \
    CMASK(C0,C1,t); \
    SBAR(); \
    GAPB(o[0]=__builtin_amdgcn_mfma_f32_32x32x16_bf16(PAF(0),VFR(0),o[0],0,0,0), C0,0); \
    GAPB(o[1]=__builtin_amdgcn_mfma_f32_32x32x16_bf16(PAF(0),VFR(4),o[1],0,0,0), C0,4); \
    KRD(GL,0); GAPB(o[0]=__builtin_amdgcn_mfma_f32_32x32x16_bf16(PAF(1),VFR(1),o[0],0,0,0), C0,8); \
    KRD(GL,1); GAPB(o[1]=__builtin_amdgcn_mfma_f32_32x32x16_bf16(PAF(1),VFR(5),o[1],0,0,0), C0,12); \
    KRD(GL,2); GAPB(o[0]=__builtin_amdgcn_mfma_f32_32x32x16_bf16(PAF(2),VFR(2),o[0],0,0,0), C1,0); \
    KRD(GL,3); GAPB(o[1]=__builtin_amdgcn_mfma_f32_32x32x16_bf16(PAF(2),VFR(6),o[1],0,0,0), C1,4); \
    GAPB(o[0]=__builtin_amdgcn_mfma_f32_32x32x16_bf16(PAF(3),VFR(3),o[0],0,0,0), C1,8); \
    GAPB(o[1]=__builtin_amdgcn_mfma_f32_32x32x16_bf16(PAF(3),VFR(7),o[1],0,0,0), C1,12); \
    }while(0)
  int t=1;
  #undef CMASK
  #define CMASK(P0,P1,t) do{}while(0)
  for(;t+5<NT;t+=2){
    STEP(pB0,pB1,pA0,pA1,t,true,true,true);     WAIT_BAR(2); ROT();
    STEP(pA0,pA1,pB0,pB1,t+1,true,true,true);   WAIT_BAR(2); ROT();
  }
  #undef CMASK
  #define CMASK(P0,P1,t) do{int jb_=(t)-(NT-4); if(jb_>=0)cmask(P0,P1,jb_,qrel,hi);}while(0)
  #define ENDW(tt) do{ if((tt)+3<NT){WAIT_BAR(2);} else if((tt)+2<NT){WAIT_BAR(1);} else {WAIT_BAR(0);} }while(0)
  for(;t+1<NT;t+=2){
    STEP(pB0,pB1,pA0,pA1,t,(t+3<NT),(t+1<NT),(t+1<NT));       ENDW(t);   ROT();
    STEP(pA0,pA1,pB0,pB1,t+1,(t+4<NT),(t+2<NT),(t+2<NT));     ENDW(t+1); ROT();
  }
  if(nK){ glds16(nK,(unsigned)__builtin_amdgcn_readfirstlane(kdst)); glds16(nK+(long)KVBLK*DMQ,(unsigned)__builtin_amdgcn_readfirstlane(kdst+SLOTB)); glds16(nK+2L*KVBLK*DMQ,(unsigned)__builtin_amdgcn_readfirstlane(kdst+2*SLOTB)); }
  STEP(pB0,pB1,pA0,pA1,NT-1,false,false,false);
  { float sacc=pB0[0]+pB0[1]; _Pragma("unroll") for(int r=2;r<16;++r)sacc+=pB0[r]; _Pragma("unroll") for(int r=0;r<16;++r)sacc+=pB1[r]; l_reg+=sacc;
    pw0=(u32x4){PKW(pB0,0),PKW(pB0,2),PKW(pB0,4),PKW(pB0,6)};pw1=(u32x4){PKW(pB0,8),PKW(pB0,10),PKW(pB0,12),PKW(pB0,14)};pw2=(u32x4){PKW(pB1,0),PKW(pB1,2),PKW(pB1,4),PKW(pB1,6)};pw3=(u32x4){PKW(pB1,8),PKW(pB1,10),PKW(pB1,12),PKW(pB1,14)};
    SBAR(); pv(o,vb0+sl_cur,PAF(0),PAF(1),PAF(2),PAF(3)); }
  #undef PKW
  #undef PAF
  #undef VFR
  #undef PIN
  #undef GAPA
  #undef GAPB
  #undef EX
  #undef VRD
  #undef KRD
  #undef STEP
  #undef ENDW
  if(nQ){
    #pragma unroll
    for(int d0=0;d0<4;++d0)qio[d0]=*reinterpret_cast<const bf16x8*>(nQ+d0*16); }
  {auto rr=__builtin_amdgcn_permlane32_swap(__float_as_uint(l_reg),__float_as_uint(l_reg),false,false);l_reg=__uint_as_float(rr[0])+__uint_as_float(rr[1]);}
  if(hi==0)wsf[32+r32]=l_reg;asm volatile("s_waitcnt lgkmcnt(0)":::"memory");
  float rli[16];
  #pragma unroll
  for(int r=0;r<16;++r)rli[r]=__builtin_amdgcn_rcpf(wsf[32+crow(r,hi)]);
  bf16*Ow=MIX+(rowbase+q0+wid*QBLK)*DMO+OC+h*D;
  { bf16*stg=(bf16*)(shm+LDS_OST)+wid*2048;
    #pragma unroll
    for(int r=0;r<16;++r){const int orow=crow(r,hi);
      #pragma unroll
      for(int d0=0;d0<2;++d0)stg[orow*64+d0*32+r32]=__float2bfloat16(o[d0][r]*rli[r]);}
    asm volatile("s_waitcnt lgkmcnt(0)":::"memory");
    #pragma unroll
    for(int i=0;i<4;++i){const int row=i*8+(lane>>3),ch=lane&7; const u32x4 v=*(const u32x4*)(stg+row*64+ch*8); *(u32x4*)(Ow+(long)row*DMO+ch*8)=v;} }
  asm volatile("s_waitcnt lgkmcnt(0)\n\ts_barrier":::"memory");
  #undef DMA_K
  #undef DMA_V
  #undef CMASK
  #undef ROT
}
constexpr int ATTN_LDS_BYTES=LDS_BYTES;
__device__ __forceinline__ void build_lut(char*shm){
  __attribute__((address_space(3))) float*bw=(__attribute__((address_space(3))) float*)((__attribute__((address_space(3))) char*)shm+LDS_LUT);
  for(int i=tid_opaque();i<LUT_N;i+=NW*64){ const int d=i-LUT_OFF; float v=-INFINITY;
    if(d>=0){ const int m=(d<=128?1:0)+(((d&3)==0&&d<=512)?1:0)+(((d&15)==0)?1:0); v=(m==0)?-INFINITY:(m==1?0.f:(m==2?1.0f:1.5849625007211562f)); }
    bw[i]=v; }
}
#undef SBAR
#undef WAIT_BAR
}

constexpr int NWAVES = 8;
constexpr int BATCH = 8, SEQ = 2048, D = 1024, T = BATCH * SEQ, NQKV = 3072, NINF = 3080, NE = 32, DE = 512, PLED = 256;
constexpr float RMS_EPS = 1e-6f, LOG2E = 1.4426950408889634f;
constexpr float C2 = 0.125f * 1.4426950408889634f;
constexpr int NPHASE = 9;

constexpr size_t MiB = 1u << 20;
constexpr size_t WS_CTL = 0, CTL_ZERO_BYTES = 64 * 1024;
constexpr size_t WS_WIN = 2 * MiB, WS_WO = 8 * MiB, WS_WPG = 10 * MiB, WS_WPP = 12 * MiB;
constexpr size_t WS_WRT = 12 * MiB + 512 * 1024  , WS_GAINS = 12 * MiB + 768 * 1024, WS_ROPE = 13 * MiB, WS_LOGF = 14 * MiB, WS_CUM = 14 * MiB + 512 * 1024, WS_LIDX = 15 * MiB;
constexpr size_t WS_LIST = 16 * MiB, WS_LISTW = 18 * MiB, WS_LISTR = 20 * MiB, WS_PB = 22 * MiB;
constexpr size_t WS_WUP = 32 * MiB, WS_WDN = 96 * MiB;
constexpr size_t WS_XN = 128 * MiB;
constexpr size_t WS_QKV = 160 * MiB;
constexpr size_t WS_H1 = 256 * MiB, WS_HG = 320 * MiB, WS_PLEB = 352 * MiB, WS_YB = 384 * MiB, WS_HID = 464 * MiB, WS_END = 504 * MiB;
constexpr int SLOT_ROWS = 40960;
constexpr int CW_CNT = 64, CW_QCTR = 128  , CW_DONE = 1024, CW_ERR = 2048;
constexpr int CW_BAR = 4096, CW_BARL = 11264;
static_assert(CW_BAR + 2 * 3456 <= CW_BARL && (CW_BARL + 2 * 2048) * 4 <= (int)CTL_ZERO_BYTES, "control words inside the memset region");

constexpr int RING_OFF = 0, RING_BYTES = 131072;
constexpr int RT_W_BYTES = 147456;
constexpr int LDSCTL_OFF = RT_W_BYTES, MISC_OFF = LDSCTL_OFF;
constexpr int L_CNT = LDSCTL_OFF + 128, L_TPRE = LDSCTL_OFF + 256, L_HIST = LDSCTL_OFF + 512, L_GBASE = LDSCTL_OFF + 640;
constexpr int L_PTAB = LDSCTL_OFF + 3072, L_QSLOT = LDSCTL_OFF + 3328;
constexpr int L_TOKE = LDSCTL_OFF + 768, L_TOKP = L_TOKE + 512, L_TOKW = L_TOKP + 512, L_TOKR = L_TOKW + 512;
constexpr int LDS_BYTES = LDSCTL_OFF + 4096;
static_assert(attn_body::ATTN_LDS_BYTES + NWAVES * 32 * 144 <= LDSCTL_OFF && L_TOKR + 256 <= L_PTAB && L_PTAB + 21 * 8 <= LDS_BYTES && LDS_BYTES <= 163840, "LDS map");

#define GAS __attribute__((address_space(1)))
#define LAS __attribute__((address_space(3)))
typedef unsigned short bf16;
typedef unsigned v4u __attribute__((ext_vector_type(4)));
typedef unsigned v2u __attribute__((ext_vector_type(2)));
typedef float f32x4 __attribute__((ext_vector_type(4)));
typedef GAS unsigned gu32;
#define RLX_AGENT __ATOMIC_RELAXED, __HIP_MEMORY_SCOPE_AGENT
#define LDS_WAIT() asm volatile("s_waitcnt lgkmcnt(0)" ::: "memory")
#define VM_WAIT() asm volatile("s_waitcnt vmcnt(0)" ::: "memory")
__device__ __forceinline__ unsigned f2bf(float f) { unsigned u = __builtin_bit_cast(unsigned, f); return (u + 0x7fffu + ((u >> 16) & 1u)) >> 16; }
typedef float pk_f32x2 __attribute__((ext_vector_type(2))); typedef __bf16 pk_bf16x2 __attribute__((ext_vector_type(2)));
__device__ __forceinline__ unsigned pk2(float lo, float hi) { const pk_f32x2 v = {lo, hi}; return __builtin_bit_cast(unsigned, __builtin_convertvector(v, pk_bf16x2)); }
__device__ __forceinline__ float bflo(unsigned w) { return __uint_as_float(w << 16); }
__device__ __forceinline__ float bfhi(unsigned w) { return __uint_as_float(w & 0xffff0000u); }

#define XB_TMO      128
#define XB_XCNT(j)  (256  + 64 * (j))
#define XB_XSUB(j)  (1280 + 64 * (j))
#define XB_XGEN(j)  (2304 + 64 * (j))
#define XB_TOP      3328
#define XB_TOPGEN   3392
#define XCD_BAR_WORDS 3456
#define XB_SPIN_CAP (1u << 18)
__device__ __forceinline__ unsigned xb_ld(unsigned* p)              { return __hip_atomic_load(p, __ATOMIC_RELAXED, __HIP_MEMORY_SCOPE_AGENT); }
__device__ __forceinline__ unsigned xb_add(unsigned* p, unsigned v) { return __hip_atomic_fetch_add(p, v, __ATOMIC_RELAXED, __HIP_MEMORY_SCOPE_AGENT); }
__device__ __forceinline__ unsigned xb_xcc_id() { return (unsigned)__builtin_amdgcn_s_getreg((3 << 11) | 20) & 0xFu; }
#define XB_SPIN(cond, bar) do { unsigned _sp = 0; while (cond) { __builtin_amdgcn_s_sleep(1); \
    if ((++_sp & 255u) == 0u) { if (xb_ld(&(bar)[XB_TMO])) break; if (_sp > XB_SPIN_CAP) { atomicAdd(&(bar)[XB_TMO], 1u); break; } } } } while (0)
#define XL_WORDS 2048
#define XL_SUB(j)   (64 * (j))
#define XL_GEN(j)   (1024 + 64 * (j))
struct XcdBarrier { unsigned* bar; unsigned* barl; unsigned x; volatile LAS unsigned* st; };
__device__ __forceinline__ void xcd_barrier_complete(unsigned* bar, unsigned x, unsigned& nloc, unsigned& nx) {
    const unsigned G = gridDim.x * gridDim.y * gridDim.z;
    unsigned sum, cnt, mine, sp = 0u;
    for (;;) {
        sum = 0u; cnt = 0u; mine = 0u;
#pragma unroll
        for (unsigned j = 0; j < 16; ++j) { const unsigned c = xb_ld(&bar[XB_XCNT(j)]); sum += c; cnt += (c > 0u) ? 1u : 0u; mine = (j == x) ? c : mine; }
        if (sum == G) break;
        __builtin_amdgcn_s_sleep(1);
        if ((++sp & 255u) == 0u) { if (xb_ld(&bar[XB_TMO])) break; if (sp > XB_SPIN_CAP) { atomicAdd(&bar[XB_TMO], 1u); break; } }
    }
    nloc = mine > 0u ? mine : 1u; nx = cnt > 0u ? cnt : 1u;
}
__device__ __forceinline__ XcdBarrier xcd_barrier_post(unsigned* bar, unsigned* barl, volatile LAS unsigned* st) {
    XcdBarrier b; b.bar = bar; b.barl = barl; b.x = xb_xcc_id(); b.st = st;
    if (threadIdx.x == 0) {
        const unsigned rank = xb_add(&bar[XB_XCNT(b.x)], 1u);
        unsigned nloc, nx; xcd_barrier_complete(bar, b.x, nloc, nx);
        const unsigned G = gridDim.x * gridDim.y * gridDim.z; unsigned ok = (G % 8u == 0u && nx == 8u) ? 1u : 0u;
#pragma unroll
        for (unsigned j = 0; j < 16; ++j) { const unsigned c = xb_ld(&bar[XB_XCNT(j)]); if (c != (j < 8u ? G / 8u : 0u)) ok = 0u; }
        if (xb_ld(&bar[XB_TMO])) ok = 0u;
        st[0] = nloc; st[1] = nx; st[2] = rank; st[3] = ok;
    }
    __syncthreads();
    return b;
}
__device__ __forceinline__ void xcdl_barrier(const XcdBarrier& b) {
    asm volatile("s_waitcnt vmcnt(0)" ::: "memory");
    __syncthreads();
    if (threadIdx.x == 0) {
        unsigned* bl = b.barl;
        __builtin_amdgcn_s_waitcnt(0);
        const unsigned nloc = b.st[0];
        const unsigned old = xb_add(&bl[XL_SUB(b.x)], 1u);
        const unsigned gen = old / nloc;
        if (old + 1u == (gen + 1u) * nloc) xb_add(&bl[XL_GEN(b.x)], 1u);
        else XB_SPIN(xb_ld(&bl[XL_GEN(b.x)]) == gen, b.bar);
        __builtin_amdgcn_fence(__ATOMIC_ACQUIRE, "agent");
        asm volatile("s_waitcnt vmcnt(0)" ::: "memory");
    }
    __syncthreads();
}
__device__ __forceinline__ void xcd_barrier(const XcdBarrier& b) {
    asm volatile("s_waitcnt vmcnt(0)" ::: "memory");
    __syncthreads();
    if (threadIdx.x == 0) {
        unsigned* bar = b.bar;
        __builtin_amdgcn_s_waitcnt(0);
        unsigned nloc = b.st[0], nx = b.st[1];
        if (nloc == 0u) { xcd_barrier_complete(bar, b.x, nloc, nx); b.st[0] = nloc; b.st[1] = nx; }
        const unsigned old = xb_add(&bar[XB_XSUB(b.x)], 1u);
        const unsigned gen = old / nloc;
        if (old + 1u == (gen + 1u) * nloc) {
            __builtin_amdgcn_fence(__ATOMIC_RELEASE, "agent");
            asm volatile("s_waitcnt vmcnt(0)" ::: "memory");
            const unsigned og = xb_add(&bar[XB_TOP], 1u);
            const unsigned tg = og / nx;
            if (og + 1u == (tg + 1u) * nx) xb_add(&bar[XB_TOPGEN], 1u);
            else XB_SPIN(xb_ld(&bar[XB_TOPGEN]) == tg, bar);
            __builtin_amdgcn_fence(__ATOMIC_ACQUIRE, "agent");
            xb_add(&bar[XB_XGEN(b.x)], 1u);
            asm volatile("s_waitcnt vmcnt(0)" ::: "memory");
        } else {
            XB_SPIN(xb_ld(&bar[XB_XGEN(b.x)]) == gen, bar);
            __builtin_amdgcn_fence(__ATOMIC_ACQUIRE, "agent");
            asm volatile("s_waitcnt vmcnt(0)" ::: "memory");
        }
    }
    __syncthreads();
}

__device__ __forceinline__ void xcd_barrier_arrive(const XcdBarrier& b) {
    asm volatile("s_waitcnt vmcnt(0)" ::: "memory");
    __syncthreads();
    if (threadIdx.x == 0) {
        unsigned* bar = b.bar;
        __builtin_amdgcn_s_waitcnt(0);
        const unsigned nloc = b.st[0], nx = b.st[1];
        const unsigned old = xb_add(&bar[XB_XSUB(b.x)], 1u);
        const unsigned gen = old / nloc;
        unsigned lead = 0u, tg = 0u;
        if (old + 1u == (gen + 1u) * nloc) {
            __builtin_amdgcn_fence(__ATOMIC_RELEASE, "agent");
            asm volatile("s_waitcnt vmcnt(0)" ::: "memory");
            const unsigned og = xb_add(&bar[XB_TOP], 1u);
            tg = og / nx; lead = 1u;
            if (og + 1u == (tg + 1u) * nx) xb_add(&bar[XB_TOPGEN], 1u);
        }
        b.st[4] = lead; b.st[5] = gen; b.st[6] = tg;
    }
}
__device__ __forceinline__ void xcd_barrier_wait(const XcdBarrier& b) {
    if (threadIdx.x == 0) {
        unsigned* bar = b.bar;
        const unsigned lead = b.st[4], gen = b.st[5], tg = b.st[6];
        if (lead) {
            XB_SPIN(xb_ld(&bar[XB_TOPGEN]) == tg, bar);
            __builtin_amdgcn_fence(__ATOMIC_ACQUIRE, "agent");
            xb_add(&bar[XB_XGEN(b.x)], 1u);
            asm volatile("s_waitcnt vmcnt(0)" ::: "memory");
        } else {
            XB_SPIN(xb_ld(&bar[XB_XGEN(b.x)]) == gen, bar);
            __builtin_amdgcn_fence(__ATOMIC_ACQUIRE, "agent");
            asm volatile("s_waitcnt vmcnt(0)" ::: "memory");
        }
    }
    __syncthreads();
}

struct Frame {
    LAS unsigned char* lds;
    volatile LAS unsigned* MISC;
    gu32* ctl;
    unsigned char* ws;
    float* out;
    int tid, lane, wave;
    int vcu, G, vblk, xl;
    __device__ __forceinline__ const float* in(int i) const {
        volatile LAS unsigned* t = (volatile LAS unsigned*)(lds + L_PTAB);
        const unsigned lo = (unsigned)__builtin_amdgcn_readfirstlane((int)t[2 * i]), hi = (unsigned)__builtin_amdgcn_readfirstlane((int)t[2 * i + 1]);
        return (const float*)(((unsigned long long)hi << 32) | lo);
    }
};
#define WSP(type, off) ((type*)(F.ws + (off)))
enum { I_X = 0, I_P, I_POS, I_GMIX, I_WIN, I_BF, I_QNA, I_KNA, I_QNB, I_KNB, I_WO, I_GFFN, I_WRG, I_BRG, I_WRE, I_BRE, I_WUP, I_WDN, I_GPLE, I_WPG, I_WPP };


__device__ __forceinline__ float wave_sum(float v) {
#pragma unroll
    for (int o = 1; o < 64; o <<= 1) v += __shfl_xor(v, o);
    return v;
}

template <int MAP> __device__ __forceinline__ int map_row(int n) {
    if (MAP == 1) { const int pn = n >> 8, r = n & 255, wc = r >> 6, bj = (r >> 5) & 1, j = r & 31; return 256 * pn + 128 * bj + 32 * wc + j; }
    if (MAP == 2) { const int bj = n >> 9, pn = (n >> 7) & 3, r = n & 127; return 256 * pn + 128 * bj + r; }
    return n;
}
constexpr int TP_STRIDE = 144, TP_BYTES = 64 * TP_STRIDE;
typedef short v4i16_t __attribute__((ext_vector_type(4)));
struct TpItem { const GAS float* src; bf16* dst; int ldn, K, kind, n0; };
__device__ __forceinline__ int map_row_rt(int kind, int n) {
    if (kind == 1) return (n & ~255) | (((n >> 5) & 1) << 7) | (((n >> 6) & 3) << 5) | (n & 31);
    if (kind == 2) return (((n >> 7) & 3) << 8) | ((n >> 9) << 7) | (n & 127);
    return n;
}
__device__ __forceinline__ void tp_load(const TpItem& t, f32x4 (&v)[16]) {
#pragma unroll
    for (int i = 0; i < 16; ++i) v[i] = __builtin_nontemporal_load((const GAS f32x4*)(t.src + (size_t)(4 * i) * t.ldn));
}
__device__ __forceinline__ void tp_store(const TpItem& t, const f32x4 (&v)[16], int lane, LAS unsigned char* scr) {
    const int kr = lane >> 4, nq = lane & 15;
#pragma unroll
    for (int i = 0; i < 16; ++i) { v2u w; w.x = pk2(v[i].x, v[i].y); w.y = pk2(v[i].z, v[i].w); *(LAS v2u*)(scr + (kr + 4 * i) * TP_STRIDE + nq * 8) = w; }
    LDS_WAIT(); asm volatile("" ::: "memory");
    const int g = lane >> 4, i16 = lane & 15, q = i16 >> 2, p = i16 & 3;
#pragma unroll
    for (int s = 0; s < 8; ++s) {
        const int C0 = 16 * (s >> 1), c = 4 * (s & 1) + g;
        const LAS unsigned char* rp = scr + (8 * c + q) * TP_STRIDE + (C0 + 4 * p) * 2;
        const v4i16_t lo = __builtin_amdgcn_ds_read_tr16_b64_v4i16((LAS v4i16_t*)rp), hi = __builtin_amdgcn_ds_read_tr16_b64_v4i16((LAS v4i16_t*)(rp + 4 * TP_STRIDE));
        const v2u a = __builtin_bit_cast(v2u, lo), b2 = __builtin_bit_cast(v2u, hi);
        v4u o; o.x = a.x; o.y = a.y; o.z = b2.x; o.w = b2.y;
        *(GAS v4u*)(t.dst + (size_t)(map_row_rt(t.kind, t.n0 + C0) + i16) * t.K + 8 * c) = o;
    }
    LDS_WAIT(); asm volatile("" ::: "memory");
}
__device__ __forceinline__ float rope_inv(int k) {
    const float INVF[8] = {1.000000000e+00f, 1.939227432e-01f, 3.760603070e-02f, 7.292664610e-03f, 1.414213562e-03f, 2.742481884e-04f, 5.318296098e-05f, 1.031338616e-05f};
    float r = INVF[0];
#pragma unroll
    for (int j = 1; j < 8; ++j) r = (k == j) ? INVF[j] : r;
    return r;
}
__device__ __forceinline__ void p0_prologue(Frame& F, const XcdBarrier& bar, const bool split) {
    const int gw = F.vcu * NWAVES + F.wave, NGW = F.G * NWAVES, lane = F.lane;
    const float* in_x = F.in(I_X); const float* in_p = F.in(I_P); const int* in_pos = (const int*)F.in(I_POS); const float* in_gmix = F.in(I_GMIX); const float* in_win = F.in(I_WIN); const float* in_bf = F.in(I_BF);
    bf16* XN = WSP(bf16, WS_XN); bf16* PB = WSP(bf16, WS_PB); float* LOGF = WSP(float, WS_LOGF); float* ROPE = WSP(float, WS_ROPE);
    LAS float* Wf = (LAS float*)(F.lds + RING_OFF);
    for (int i = F.tid; i < 1024 * 2; i += NWAVES * 64) { const int k = i >> 1, hf = i & 1; *(LAS f32x4*)(Wf + k * 8 + hf * 4) = *(const GAS f32x4*)((const GAS float*)in_win + (size_t)k * NINF + 3072 + hf * 4); }
    {
        const float* wrg = F.in(I_WRG); const float* wre = F.in(I_WRE); bf16* img = WSP(bf16, WS_WRT);
        const int per = (48 * 1024 + F.G - 1) / F.G;
        for (int i = F.tid; i < per; i += NWAVES * 64) { const int idx = F.vblk * per + i; if (idx < 48 * 1024) { const int n = idx >> 10, k = idx & 1023;
            float w = 0.f;
            if (n < 4) w = wrg[(size_t)k * 4 + n]; else if (n < 36) { const int g = (n - 4) >> 3, j = (n - 4) & 7; w = wre[((size_t)g * 1024 + k) * 8 + j]; }
            const unsigned hi = f2bf(w); const float lo = w - __uint_as_float(hi << 16);
            img[(size_t)n * 1024 + k] = (bf16)hi; img[(size_t)(48 + n) * 1024 + k] = (bf16)f2bf(lo); } }
    }
    if (F.vblk == 0 && F.tid < 256) { const int w = F.tid >> 6, l = F.tid & 63; const float* s = F.in(I_QNA + w); WSP(float, WS_GAINS)[F.tid] = s[l]; }
    __syncthreads();
    LAS unsigned char* tscr = F.lds + RING_OFF + 32768 + F.wave * TP_BYTES;
    constexpr int I_IN = 48 * 16, I_O = 16 * 16, I_PG = 16 * 16, I_PP = 16 * 4;
    constexpr int NITEMS = I_IN + I_O + I_PG + I_PP;
    const float* w_o = F.in(I_WO); const float* w_pg = F.in(I_WPG); const float* w_pp = F.in(I_WPP);
    auto decode = [&](int it) -> TpItem {
        int r = it; const float* W; bf16* WT; int ldn, K, kind, nb, kb;
        if (r < I_IN) { W = in_win; WT = WSP(bf16, WS_WIN); ldn = NINF; K = D; kind = 1; nb = r % 48; kb = r / 48; }
        else if ((r -= I_IN) < I_O) { W = w_o; WT = WSP(bf16, WS_WO); ldn = D; K = D; kind = 0; nb = r % 16; kb = r / 16; }
        else if ((r -= I_O) < I_PG) { W = w_pg; WT = WSP(bf16, WS_WPG); ldn = D; K = D; kind = 0; nb = r % 16; kb = r / 16; }
        else { r -= I_PG; W = w_pp; WT = WSP(bf16, WS_WPP); ldn = D; K = PLED; kind = 0; nb = r % 16; kb = r / 16; }
        TpItem t; t.ldn = ldn; t.K = K; t.kind = kind; t.n0 = nb * 64;
        t.src = (const GAS float*)W + (size_t)(kb * 64 + (lane >> 4)) * ldn + nb * 64 + 4 * (lane & 15); t.dst = WT + kb * 64; return t; };
    int it = gw;
    if (it < NITEMS) {
        TpItem A = decode(it), B = A; f32x4 va[16], vb[16]; tp_load(A, va);
        for (;;) {
            const int it2 = it + NGW; const bool has2 = it2 < NITEMS;
            if (has2) { B = decode(it2); tp_load(B, vb); }
            tp_store(A, va, lane, tscr);
            if (!has2) break;
            const int it3 = it2 + NGW; const bool has3 = it3 < NITEMS;
            if (has3) { A = decode(it3); tp_load(A, va); }
            tp_store(B, vb, lane, tscr);
            if (!has3) break;
            it = it3;
        }
    }

    if (split) xcd_barrier_arrive(bar);
    {
        f32x4 gm[4];
#pragma unroll
        for (int j = 0; j < 4; ++j) gm[j] = *(const GAS f32x4*)((const GAS float*)in_gmix + 4 * lane + 256 * j);
        constexpr int RB = 4;
        const int RPW = ((T + NGW - 1) / NGW + RB - 1) / RB * RB, mend = (gw + 1) * RPW < T ? (gw + 1) * RPW : T;
        for (int m0 = gw * RPW; m0 < mend; m0 += RB) {
            f32x4 v[RB][4], pv[RB]; float s2[RB];
#pragma unroll
            for (int r = 0; r < RB; ++r) { const GAS f32x4* xr = (const GAS f32x4*)(in_x + (size_t)(m0 + r) * D) + lane;
#pragma unroll
                for (int j = 0; j < 4; ++j) v[r][j] = xr[64 * j];
                pv[r] = *((const GAS f32x4*)(in_p + (size_t)(m0 + r) * PLED) + lane); }
#pragma unroll
            for (int r = 0; r < RB; ++r) { float s = 0.f;
#pragma unroll
                for (int j = 0; j < 4; ++j) s += (v[r][j].x * v[r][j].x + v[r][j].y * v[r][j].y) + (v[r][j].z * v[r][j].z + v[r][j].w * v[r][j].w);
                s2[r] = s; }
#pragma unroll
            for (int o = 1; o < 64; o <<= 1) {
#pragma unroll
                for (int r = 0; r < RB; ++r) s2[r] += __shfl_xor(s2[r], o); }
            float a[RB][8];
#pragma unroll
            for (int r = 0; r < RB; ++r) { const float rstd = 1.f / sqrtf(s2[r] * (1.f / D) + RMS_EPS);
                GAS unsigned long long* o8 = (GAS unsigned long long*)(XN + (size_t)(m0 + r) * D) + lane;
#pragma unroll
                for (int h = 0; h < 8; ++h) a[r][h] = 0.f;
#pragma unroll
                for (int j = 0; j < 4; ++j) { v[r][j] = v[r][j] * rstd * gm[j]; o8[64 * j] = (unsigned long long)pk2(v[r][j].x, v[r][j].y) | ((unsigned long long)pk2(v[r][j].z, v[r][j].w) << 32); }
                *((GAS unsigned long long*)(PB + (size_t)(m0 + r) * PLED) + lane) = (unsigned long long)pk2(pv[r].x, pv[r].y) | ((unsigned long long)pk2(pv[r].z, pv[r].w) << 32); }
#pragma unroll
            for (int j = 0; j < 4; ++j) { asm volatile("" ::: "memory");
#pragma unroll
                for (int c = 0; c < 4; ++c) { const int k = 4 * lane + 256 * j + c; const f32x4 w0 = *(const LAS f32x4*)(Wf + k * 8), w1 = *(const LAS f32x4*)(Wf + k * 8 + 4);
#pragma unroll
                    for (int r = 0; r < RB; ++r) { const float av = v[r][j][c];
                        a[r][0] += av * w0.x; a[r][1] += av * w0.y; a[r][2] += av * w0.z; a[r][3] += av * w0.w; a[r][4] += av * w1.x; a[r][5] += av * w1.y; a[r][6] += av * w1.z; a[r][7] += av * w1.w; } } }
            const bool b5 = lane & 32, b4 = lane & 16, b3 = lane & 8;
#pragma unroll
            for (int r = 0; r < RB; ++r) { const int m = m0 + r;
                float b[4], c2[2], d1;
#pragma unroll
                for (int i = 0; i < 4; ++i) { const float snd = b5 ? a[r][i] : a[r][i + 4], kp = b5 ? a[r][i + 4] : a[r][i]; b[i] = kp + __shfl_xor(snd, 32); }
#pragma unroll
                for (int i = 0; i < 2; ++i) { const float snd = b4 ? b[i] : b[i + 2], kp = b4 ? b[i + 2] : b[i]; c2[i] = kp + __shfl_xor(snd, 16); }
                { const float snd = b3 ? c2[0] : c2[1], kp = b3 ? c2[1] : c2[0]; d1 = kp + __shfl_xor(snd, 8); }
                d1 += __shfl_xor(d1, 4); d1 += __shfl_xor(d1, 2); d1 += __shfl_xor(d1, 1);
                if ((lane & 7) == 0) { const int h = lane >> 3; const float z = d1 + in_bf[h]; LOGF[(size_t)m * 8 + h] = fminf(z, 0.f) - log1pf(expf(-fabsf(z))); }
                if (lane < 8) { const float ang = (float)in_pos[m] * rope_inv(lane); double rv = (double)ang * 0.15915494309189535; rv -= rint(rv);
                    ROPE[(size_t)m * 16 + lane] = __builtin_amdgcn_cosf((float)rv); ROPE[(size_t)m * 16 + 8 + lane] = __builtin_amdgcn_sinf((float)rv); }
            }
        }
    }
}

constexpr int TPH_BYTES = 32 * TP_STRIDE;
__device__ __forceinline__ void tph_decode(Frame& F, int hi, int lane, const float* w_up, const float* w_dn, TpItem& t) {
    const float* W; bf16* WT; int ldn, K, kind, nb, kb;
    if (hi < NE * 32 * 16) { const int e = hi >> 9, q = hi & 511; W = w_up + (size_t)e * D * 1024; WT = WSP(bf16, WS_WUP) + (size_t)e * 1024 * D; ldn = 1024; K = D; kind = 2; nb = q & 15; kb = q >> 4; }
    else { const int r = hi - NE * 32 * 16, e = r >> 8, q = r & 255; W = w_dn + (size_t)e * DE * D; WT = WSP(bf16, WS_WDN) + (size_t)e * D * DE; ldn = D; K = DE; kind = 0; nb = q & 15; kb = q >> 4; }
    t.ldn = ldn; t.K = K; t.kind = kind; t.n0 = nb * 64;
    t.src = (const GAS float*)W + (size_t)(kb * 32 + (lane >> 4)) * ldn + nb * 64 + 4 * (lane & 15); t.dst = WT + kb * 32;
}
__device__ __forceinline__ void tph_load(const TpItem& t, f32x4 (&v)[8]) {
#pragma unroll
    for (int i = 0; i < 8; ++i) v[i] = __builtin_nontemporal_load((const GAS f32x4*)(t.src + (size_t)(4 * i) * t.ldn));
}
__device__ __forceinline__ void tph_store(const TpItem& t, const f32x4 (&v)[8], int lane, LAS unsigned char* scr) {
    const int kr = lane >> 4, nq = lane & 15;
#pragma unroll
    for (int i = 0; i < 8; ++i) { v2u w; w.x = pk2(v[i].x, v[i].y); w.y = pk2(v[i].z, v[i].w); *(LAS v2u*)(scr + (kr + 4 * i) * TP_STRIDE + nq * 8) = w; }
    LDS_WAIT(); asm volatile("" ::: "memory");
    const int g = lane >> 4, i16 = lane & 15, q = i16 >> 2, p = i16 & 3;
#pragma unroll
    for (int s = 0; s < 4; ++s) {
        const LAS unsigned char* rp = scr + (8 * g + q) * TP_STRIDE + (16 * s + 4 * p) * 2;
        const v4i16_t lo = __builtin_amdgcn_ds_read_tr16_b64_v4i16((LAS v4i16_t*)rp), hi = __builtin_amdgcn_ds_read_tr16_b64_v4i16((LAS v4i16_t*)(rp + 4 * TP_STRIDE));
        const v2u a = __builtin_bit_cast(v2u, lo), b2 = __builtin_bit_cast(v2u, hi);
        v4u o; o.x = a.x; o.y = a.y; o.z = b2.x; o.w = b2.y;
        __builtin_nontemporal_store(o, (GAS v4u*)(t.dst + (size_t)(map_row_rt(t.kind, t.n0 + 16 * s) + i16) * t.K + 8 * g));
    }
    LDS_WAIT(); asm volatile("" ::: "memory");
}
__device__ __forceinline__ void p2_convert_slot(Frame& F, int slot, int nslots, LAS unsigned char* scr) {
    const int tid = tid_opaque(), lane = tid & 63, wave = __builtin_amdgcn_readfirstlane(tid >> 6);
    const int gw = F.vcu * NWAVES + wave, NGW = F.G * NWAVES;
    constexpr int NHALF = NE * 32 * 16 + NE * 16 * 16;
    const float* w_up = F.in(I_WUP); const float* w_dn = F.in(I_WDN);
    LAS unsigned char* ws_ = scr + wave * TPH_BYTES;
    const int per = (NHALF + NGW - 1) / NGW;
    const int i0 = (slot * per) / nslots, i1 = ((slot + 1) * per) / nslots;
    for (int i = i0; i < i1; i += 6) {
        TpItem t[6]; f32x4 v[6][8]; bool ok[6];
#pragma unroll
        for (int q = 0; q < 6; ++q) { const int hq = gw + (i + q) * NGW; ok[q] = (i + q < i1) && hq < NHALF; if (ok[q]) { tph_decode(F, hq, lane, w_up, w_dn, t[q]); tph_load(t[q], v[q]); } }
#pragma unroll
        for (int q = 0; q < 6; ++q) if (ok[q]) tph_store(t[q], v[q], lane, ws_);
    }
}

__device__ __forceinline__ void p1_cumsum(Frame& F, int bh) {
    const int b = bh >> 3, h = bh & 7, tid = F.tid, lane = F.lane;
    const float* lf = WSP(float, WS_LOGF) + (size_t)b * SEQ * 8 + h;
    float v[4];
#pragma unroll
    for (int j = 0; j < 4; ++j) v[j] = lf[(size_t)(4 * tid + j) * 8] * LOG2E;
    v[1] += v[0]; v[2] += v[1]; v[3] += v[2];
    float inc = v[3];
#pragma unroll
    for (int o = 1; o < 64; o <<= 1) { const float u = __shfl_up(inc, o); if (lane >= o) inc += u; }
    volatile LAS float* wt = (volatile LAS float*)(F.lds + RING_OFF);
    if (lane == 63) wt[F.wave] = inc;
    __syncthreads();
    float off = inc - v[3];
    for (int w = 0; w < F.wave; ++w) off += wt[w];
    float* co = WSP(float, WS_CUM) + (size_t)bh * SEQ + 4 * tid;
#pragma unroll
    for (int j = 0; j < 4; ++j) co[j] = off + v[j];
    __syncthreads();
}

typedef short rbf16x8 __attribute__((ext_vector_type(8)));
__device__ __forceinline__ void split_hl(const f32x4 a, const f32x4 b, rbf16x8& hi, rbf16x8& lo) {
    const float v[8] = {a.x, a.y, a.z, a.w, b.x, b.y, b.z, b.w};
#pragma unroll
    for (int j = 0; j < 8; ++j) { const unsigned h = f2bf(v[j]); hi[j] = (short)h; lo[j] = (short)f2bf(v[j] - __uint_as_float(h << 16)); }
}
__device__ __forceinline__ void p3b_router(Frame& F) {
    const int tid = F.tid, lane = F.lane, wave = F.wave, r16 = lane & 15, kq = lane >> 4;
    const float* in_brg = F.in(I_BRG); const float* in_bre = F.in(I_BRE); const float* in_gffn = F.in(I_GFFN);
    const float* H1 = WSP(float, WS_H1); int* LIST = WSP(int, WS_LIST); int* LIDX = WSP(int, WS_LIDX); float* LISTW = WSP(float, WS_LISTW); float* LISTR = WSP(float, WS_LISTR);
    const bf16* img = WSP(bf16, WS_WRT);
    LAS float* part = (LAS float*)(F.lds);
    LAS float* pssq = (LAS float*)(F.lds + 98304);
    LAS float* logit = (LAS float*)(F.lds + 98304 + 2048);
    LAS float* tssq = (LAS float*)(F.lds + 98304 + 2048 + 12288);
    volatile LAS int* hist = (volatile LAS int*)(F.lds + L_HIST);
    volatile LAS int* gbase = (volatile LAS int*)(F.lds + L_GBASE);
    volatile LAS int* tokE = (volatile LAS int*)(F.lds + L_TOKE);
    volatile LAS float* tokW = (volatile LAS float*)(F.lds + L_TOKW);
    volatile LAS float* tokR = (volatile LAS float*)(F.lds + L_TOKR);
    if (tid < 32) hist[tid] = 0;
    const int kb = wave * 128 + kq * 8;
    rbf16x8 bh[4][3], bl[4][3]; f32x4 gv[4][2];
#pragma unroll
    for (int s = 0; s < 4; ++s) {
#pragma unroll
        for (int nb = 0; nb < 3; ++nb) { bh[s][nb] = *(const GAS rbf16x8*)(img + (size_t)(nb * 16 + r16) * 1024 + kb + 32 * s); bl[s][nb] = *(const GAS rbf16x8*)(img + (size_t)(48 + nb * 16 + r16) * 1024 + kb + 32 * s); }
        gv[s][0] = *(const GAS f32x4*)((const GAS float*)in_gffn + kb + 32 * s); gv[s][1] = *(const GAS f32x4*)((const GAS float*)in_gffn + kb + 32 * s + 4); }
    for (int grp = F.vcu; grp < T / 64; grp += F.G) {
#pragma unroll
        for (int tb = 0; tb < 4; ++tb) {
            const GAS float* hr = (const GAS float*)H1 + (size_t)(grp * 64 + tb * 16 + r16) * D + kb;
            f32x4 acc[3] = {(f32x4){0.f, 0.f, 0.f, 0.f}, (f32x4){0.f, 0.f, 0.f, 0.f}, (f32x4){0.f, 0.f, 0.f, 0.f}}; float s2 = 0.f;
            f32x4 h0[4], h1v[4];
#pragma unroll
            for (int s = 0; s < 4; ++s) { h0[s] = *(const GAS f32x4*)(hr + 32 * s); h1v[s] = *(const GAS f32x4*)(hr + 32 * s + 4); }
#pragma unroll
            for (int s = 0; s < 4; ++s) {
                s2 += (h0[s].x * h0[s].x + h0[s].y * h0[s].y) + (h0[s].z * h0[s].z + h0[s].w * h0[s].w) + (h1v[s].x * h1v[s].x + h1v[s].y * h1v[s].y) + (h1v[s].z * h1v[s].z + h1v[s].w * h1v[s].w);
                rbf16x8 ah, al; split_hl(h0[s] * gv[s][0], h1v[s] * gv[s][1], ah, al);
#pragma unroll
                for (int nb = 0; nb < 3; ++nb) {
                    acc[nb] = __builtin_amdgcn_mfma_f32_16x16x32_bf16(ah, bh[s][nb], acc[nb], 0, 0, 0);
                    acc[nb] = __builtin_amdgcn_mfma_f32_16x16x32_bf16(ah, bl[s][nb], acc[nb], 0, 0, 0);
                    acc[nb] = __builtin_amdgcn_mfma_f32_16x16x32_bf16(al, bh[s][nb], acc[nb], 0, 0, 0); }
            }
            s2 += __shfl_xor(s2, 16); s2 += __shfl_xor(s2, 32);
            if (kq == 0) pssq[wave * 64 + tb * 16 + r16] = s2;
#pragma unroll
            for (int nb = 0; nb < 3; ++nb)
#pragma unroll
                for (int r = 0; r < 4; ++r) part[(wave * 64 + tb * 16 + 4 * kq + r) * 48 + nb * 16 + r16] = acc[nb][r];
        }
        __syncthreads();
        for (int i = tid; i < 64 * 48; i += NWAVES * 64) { float s = 0.f;
#pragma unroll
            for (int w = 0; w < 8; ++w) s += part[w * 3072 + i];
            logit[i] = s; }
        if (tid < 64) { float s = 0.f;
#pragma unroll
            for (int w = 0; w < 8; ++w) s += pssq[w * 64 + tid];
            tssq[tid] = s; }
        __syncthreads();
        if (tid < 64) {
            const float rs = 1.f / sqrtf(tssq[tid] * (1.f / D) + RMS_EPS); const LAS float* lt = logit + tid * 48;
            float lg[4];
#pragma unroll
            for (int g = 0; g < 4; ++g) lg[g] = lt[g] * rs + in_brg[g];
            int gi = 0; float gm = lg[0];
#pragma unroll
            for (int g = 1; g < 4; ++g) if (lg[g] > gm) { gm = lg[g]; gi = g; }
            float den = 0.f;
#pragma unroll
            for (int g = 0; g < 4; ++g) den += expf(lg[g] - gm);
            const float gw = 1.0f / den;
            float le[8];
#pragma unroll
            for (int j = 0; j < 8; ++j) le[j] = lt[4 + 8 * gi + j] * rs + in_bre[gi * 8 + j];
            int i0 = 0; float v0 = le[0];
#pragma unroll
            for (int j = 1; j < 8; ++j) if (le[j] > v0) { v0 = le[j]; i0 = j; }
            int i1 = -1; float v1 = -3.4e38f;
#pragma unroll
            for (int j = 0; j < 8; ++j) if (j != i0 && le[j] > v1) { v1 = le[j]; i1 = j; }
            const float e1 = expf(v1 - v0), sden = 1.0f / (1.0f + e1);
            tokE[2 * tid] = gi * 8 + i0; tokE[2 * tid + 1] = gi * 8 + i1; tokW[2 * tid] = gw * sden; tokW[2 * tid + 1] = gw * e1 * sden; tokR[tid] = rs;
        }
        __syncthreads();
        int e = 0, pl = 0;
        if (tid < 128) { e = tokE[tid]; pl = __hip_atomic_fetch_add((LAS int*)hist + e, 1, __ATOMIC_RELAXED, __HIP_MEMORY_SCOPE_WORKGROUP); }
        __syncthreads();
        if (tid < 32) { const int hc = hist[tid]; gbase[tid] = hc ? (int)__hip_atomic_fetch_add((unsigned*)(F.ctl + CW_CNT + tid), (unsigned)hc, RLX_AGENT) : 0; }
        __syncthreads();
        if (tid < 128) { const int pos = gbase[e] + pl, tok = grp * 64 + (tid >> 1); const size_t li = (size_t)e * T + pos;
            LIST[li] = tok * 2 + (tid & 1); LISTW[li] = tokW[tid]; LISTR[li] = tokR[tid >> 1]; LIDX[tok * 2 + (tid & 1)] = (int)li; }
        __syncthreads();
        if (tid < 32) hist[tid] = 0;
        __syncthreads();
    }
}

__device__ __forceinline__ void load_expert_table(Frame& F) {
    volatile LAS int* cnt = (volatile LAS int*)(F.lds + L_CNT); volatile LAS int* tpre = (volatile LAS int*)(F.lds + L_TPRE);
    if (F.tid < 32) cnt[F.tid] = (int)__hip_atomic_load(F.ctl + CW_CNT + F.tid, RLX_AGENT);
    __syncthreads();
    if (F.tid == 0) { int s = 0; for (int e = 0; e < 32; ++e) { tpre[e] = s; s += (cnt[e] + 255) >> 8; } tpre[32] = s; }
    __syncthreads();
}

__device__ __forceinline__ void p6a_rows(Frame& F) {
    const int gw = F.vcu * NWAVES + F.wave, NGW = F.G * NWAVES, lane = F.lane;
    volatile LAS int* tpre = (volatile LAS int*)(F.lds + L_TPRE);
    const float* in_gple = F.in(I_GPLE); const int* LIDX = WSP(int, WS_LIDX); const float* H1 = WSP(float, WS_H1); const bf16* YB = WSP(bf16, WS_YB); bf16* HN = WSP(bf16, WS_XN);
    f32x4 gp[4];
#pragma unroll
    for (int j = 0; j < 4; ++j) gp[j] = *(const GAS f32x4*)((const GAS float*)in_gple + 4 * lane + 256 * j);
    const int RPW = (T + NGW - 1) / NGW, mend = (gw + 1) * RPW < T ? (gw + 1) * RPW : T;
    constexpr int RB = 2;
    for (int m0 = gw * RPW; m0 < mend; m0 += RB) {
        int i0[RB], i1[RB];
#pragma unroll
        for (int r = 0; r < RB; ++r) { const int m = (m0 + r < mend) ? m0 + r : mend - 1; i0[r] = LIDX[2 * m]; i1[r] = LIDX[2 * m + 1]; }
        f32x4 hv[RB][4]; v2u ya[RB][4], yb[RB][4];
#pragma unroll
        for (int r = 0; r < RB; ++r) { const int m = (m0 + r < mend) ? m0 + r : mend - 1;
            const size_t s0 = (size_t)tpre[i0[r] >> 14] * 256 + (i0[r] & 16383), s1 = (size_t)tpre[i1[r] >> 14] * 256 + (i1[r] & 16383);
            const GAS f32x4* hr = (const GAS f32x4*)(H1 + (size_t)m * D) + lane;
            const GAS v2u* y0 = (const GAS v2u*)(YB + s0 * D) + lane; const GAS v2u* y1 = (const GAS v2u*)(YB + s1 * D) + lane;
#pragma unroll
            for (int j = 0; j < 4; ++j) { hv[r][j] = hr[64 * j]; ya[r][j] = y0[64 * j]; yb[r][j] = y1[64 * j]; } }
#pragma unroll
        for (int r = 0; r < RB; ++r) { if (m0 + r < mend) { const int m = m0 + r;
            f32x4 v[4]; float s2 = 0.f;
#pragma unroll
            for (int j = 0; j < 4; ++j) { const f32x4 h = hv[r][j]; const v2u a = ya[r][j], b = yb[r][j];
                v[j].x = h.x + (bflo(a.x) + bflo(b.x)); v[j].y = h.y + (bfhi(a.x) + bfhi(b.x)); v[j].z = h.z + (bflo(a.y) + bflo(b.y)); v[j].w = h.w + (bfhi(a.y) + bfhi(b.y));
                s2 += (v[j].x * v[j].x + v[j].y * v[j].y) + (v[j].z * v[j].z + v[j].w * v[j].w); }
            const float rstd = 1.f / sqrtf(wave_sum(s2) * (1.f / D) + RMS_EPS);
            GAS unsigned long long* h8 = (GAS unsigned long long*)(WSP(bf16, WS_QKV) + (size_t)m * D) + lane;
            GAS unsigned long long* o8 = (GAS unsigned long long*)(HN + (size_t)m * D) + lane;
#pragma unroll
            for (int j = 0; j < 4; ++j) { h8[64 * j] = (unsigned long long)pk2(v[j].x, v[j].y) | ((unsigned long long)pk2(v[j].z, v[j].w) << 32);
                const f32x4 n = v[j] * rstd * gp[j]; o8[64 * j] = (unsigned long long)pk2(n.x, n.y) | ((unsigned long long)pk2(n.z, n.w) << 32); } } }
    }
}

struct Args { const float* in[21]; float* out; unsigned char* ws; int ph_lo, ph_hi, li, pad; };
__global__ void __launch_bounds__(NWAVES * 64, 2) mega_fwd(Args args) {
    extern __shared__ __attribute__((aligned(16))) unsigned char lds[];
    Frame F;
    F.lds = (LAS unsigned char*)lds;
    F.MISC = (volatile LAS unsigned*)(F.lds + MISC_OFF);
    F.tid = threadIdx.x; F.lane = F.tid & 63; F.wave = __builtin_amdgcn_readfirstlane(F.tid >> 6);
    F.G = gridDim.x;
    F.ws = args.ws; F.out = args.out; F.ctl = (gu32*)(args.ws + WS_CTL);
    for (int u = F.tid; u < (LDS_BYTES - LDSCTL_OFF) / 4; u += NWAVES * 64) ((LAS unsigned*)(F.lds + LDSCTL_OFF))[u] = 0u;
    __syncthreads();
    if (F.tid < 21) { const unsigned long long pv = (unsigned long long)args.in[F.tid]; volatile LAS unsigned* t = (volatile LAS unsigned*)(F.lds + L_PTAB); t[2 * F.tid] = (unsigned)pv; t[2 * F.tid + 1] = (unsigned)(pv >> 32); }
    __syncthreads();
    const XcdBarrier bar = xcd_barrier_post((unsigned*)(F.ctl + CW_BAR) + args.li * XCD_BAR_WORDS, (unsigned*)(F.ctl + CW_BARL) + args.li * XL_WORDS, F.MISC + 8);
    F.xl = (int)F.MISC[8 + 3];
    { const int bx = F.xl ? (int)F.MISC[8 + 2] * 8 + (int)bar.x : (int)blockIdx.x; F.vblk = bx; F.vcu = (F.G % 8 == 0) ? (bx % 8) * (F.G / 8) + bx / 8 : bx; }
#define GRID_BAR() xcd_barrier(bar)
#define SEAM_BAR(k) do { if (F.xl && ((k) == 1 || (k) == 2 || (k) == 3 || (k) == 7)) xcdl_barrier(bar); else xcd_barrier(bar); } while (0)
    const int lo = args.ph_lo, hi = args.ph_hi;
#define IN(k) (lo <= (k) && (k) < hi)
#define BOTH(k) (IN(k) && IN((k) + 1))
#define PHASE_BEGIN() do { const int t_ = tid_opaque(); F.tid = t_; F.lane = t_ & 63; F.wave = __builtin_amdgcn_readfirstlane(t_ >> 6); } while (0)
    volatile LAS int* l_cnt = (volatile LAS int*)(F.lds + L_CNT); volatile LAS int* l_tpre = (volatile LAS int*)(F.lds + L_TPRE);

#define PHASE(k, ...) if (IN(k)) { PHASE_BEGIN(); __VA_ARGS__ if (BOTH(k)) SEAM_BAR(k); }
    if (IN(0)) { PHASE_BEGIN(); const bool split = F.xl && BOTH(0); p0_prologue(F, bar, split);
        if (BOTH(0)) { if (split) { xcdl_barrier(bar); xcd_barrier_wait(bar); } else GRID_BAR(); } }

    PHASE(1,
        if (F.G % 8 == 0 && F.G >= 64) { const int per = F.G / 8; if (F.vcu % per < 8) p1_cumsum(F, (F.vcu / per) * 8 + F.vcu % per); }
        else for (int bh = F.vblk; bh < 64; bh += F.G) p1_cumsum(F, bh);
        pg8::SrcDense g{WSP(bf16, WS_XN), WSP(bf16, WS_WIN), D}; pg8::StaticOrder S; S.init(T, NQKV, F.G, F.vblk);
        pg8::EpiQKV E{WSP(bf16, WS_QKV), WSP(float, WS_GAINS), WSP(float, WS_ROPE), C2};
        pg8::gemm_phase<pg8::EpiQKV, pg8::StaticOrder, pg8::SrcDense, true, true>(F.lds + RING_OFF, D, S, g, E);
    )

    PHASE(2,
        LAS unsigned char* cscr = F.lds + RING_OFF + attn_body::ATTN_LDS_BYTES;
        attn_body::build_lut((char*)lds + RING_OFF);
        const attn_body::bf16* qkv = (const attn_body::bf16*)WSP(bf16, WS_QKV); attn_body::bf16* mixo = (attn_body::bf16*)WSP(bf16, WS_XN); const float* cum = WSP(float, WS_CUM);
        const int spm = ((F.vcu >> 2) & 1) ? 0x14 : 0x0A;
        const int sp = 0; (void)sp;
        int cs = 0, un = 0;
        auto unit_of = [&](const int j, int& kind, int& b, int& h, int& qb) -> bool {
            const int I = F.vcu + (j >> 1) * F.G; if (I >= 512) return false;
            kind = I >> 8; const int v = I & 255, bh = v >> 2, s = v & 3; b = bh >> 3; h = bh & 7; qb = (j & 1) ? 7 - s : s; return true; };
        attn_body::bf16x8 qio[4]; bool pre = false;
        if (spm & 1) p2_convert_slot(F, cs++, 2, cscr);
        _Pragma("unroll 1")
        for (int j = 0;; ++j) {
            int kind, b, h, qb; if (!unit_of(j, kind, b, h, qb)) break;
            const bool slot_after = cs < 2 && ((spm >> (un + 1)) & 1);
            int nk, nb, nh, nqb; const bool chain = unit_of(j + 1, nk, nb, nh, nqb) && !slot_after;
            const attn_body::bf16* nQ = nullptr; const attn_body::bf16* nK = nullptr;
            if (chain) attn_body::next_ptrs(nk, nb, nh, nqb, qkv, nQ, nK);
            if (kind == 0) attn_body::attn_unit<0>(b, h, qb, qkv, cum, mixo, (char*)lds + RING_OFF, pre, qio, nQ, nK);
            else           attn_body::attn_unit<1>(b, h, qb, qkv, cum, mixo, (char*)lds + RING_OFF, pre, qio, nQ, nK);
            pre = chain;
            if (slot_after) p2_convert_slot(F, cs++, 2, cscr);
            ++un;
        }
        while (cs < 2) p2_convert_slot(F, cs++, 2, cscr);
    )

    PHASE(3,
        { pg8::SrcDense g{WSP(bf16, WS_XN), WSP(bf16, WS_WO), D}; pg8::StaticOrder S; S.init(T, D, F.G, F.vblk);
          pg8::EpiRes E{F.in(I_X), WSP(float, WS_H1), WSP(bf16, WS_HG), F.in(I_GFFN)};
          pg8::gemm_phase<pg8::EpiRes, pg8::StaticOrder, pg8::SrcDense, true, true>(F.lds + RING_OFF, D, S, g, E); }
    )

    if (IN(4)) { PHASE_BEGIN(); p3b_router(F);
        if (BOTH(4)) xcd_barrier_arrive(bar);
        { PHASE_BEGIN();
          pg8::SrcDense g{WSP(bf16, WS_PB), WSP(bf16, WS_WPP), PLED}; pg8::StaticOrder S; S.init(T, D, F.G, F.vblk);
          pg8::EpiBf16 E{WSP(bf16, WS_PLEB), D};
          pg8::gemm_phase<pg8::EpiBf16, pg8::StaticOrder, pg8::SrcDense, true, true>(F.lds + RING_OFF, PLED, S, g, E); }
        if (BOTH(4)) xcd_barrier_wait(bar); }

    PHASE(5,
        load_expert_table(F);
        pg8::MoeArgs M{WSP(bf16, WS_HG), WSP(bf16, WS_WUP), WSP(bf16, WS_HID), WSP(bf16, WS_WDN), WSP(bf16, WS_YB), WSP(int, WS_LIST), WSP(float, WS_LISTR), WSP(float, WS_LISTW),
                       (unsigned*)(F.ctl + CW_QCTR), (unsigned*)(F.ctl + CW_DONE), (unsigned*)(F.ctl + CW_ERR), l_tpre, l_cnt, (volatile LAS int*)(F.lds + L_QSLOT), T, (F.G % 8 == 0) ? (F.vcu / (F.G / 8)) & 7 : (int)(blockIdx.x & 7)};
        pg8::moe_phase(F.lds + RING_OFF, M);
    )

    PHASE(7, load_expert_table(F); p6a_rows(F);)

    PHASE(8,
        pg8::SrcDense g{WSP(bf16, WS_XN), WSP(bf16, WS_WPG), D}; pg8::StaticOrder S; S.init(T, D, F.G, F.vblk);
        pg8::EpiFinal E{F.out, WSP(bf16, WS_PLEB), WSP(bf16, WS_QKV)};
        pg8::gemm_phase<pg8::EpiFinal, pg8::StaticOrder, pg8::SrcDense, true, true>(F.lds + RING_OFF, D, S, g, E);
    )
#undef PHASE
#undef IN
#undef BOTH
#undef GRID_BAR
}

extern "C" void kernel_launch(void* const* d_in, const int* in_sizes, int n_in, void* d_out, int out_size, void* d_ws, size_t ws_size, hipStream_t stream) {
    static int grid = 0;
    if (grid == 0) {
        if (n_in != 21 || out_size != T * D || ws_size < WS_END) { fprintf(stderr, "kernel_launch: unexpected problem (n_in %d, out %d, ws %zu)\n", n_in, out_size, ws_size); grid = -1; return; }
        int dev = 0, cus = 0;
        if (hipGetDevice(&dev) != hipSuccess || hipDeviceGetAttribute(&cus, hipDeviceAttributeMultiprocessorCount, dev) != hipSuccess) { grid = -1; return; }
        if (hipFuncSetAttribute((const void*)mega_fwd, hipFuncAttributeMaxDynamicSharedMemorySize, LDS_BYTES) != hipSuccess) { fprintf(stderr, "kernel_launch: hipFuncSetAttribute failed\n"); grid = -1; return; }
        (void)hipGetLastError();
        grid = cus;
    }
    if (grid < 0) return;
    (void)hipMemsetAsync((char*)d_ws + WS_CTL, 0, CTL_ZERO_BYTES, stream);
    Args a{};
    for (int i = 0; i < 21; ++i) a.in[i] = (const float*)d_in[i];
    a.out = (float*)d_out; a.ws = (unsigned char*)d_ws;
    a.ph_lo = 0; a.ph_hi = NPHASE; a.li = 0;
    hipLaunchKernelGGL(mega_fwd, dim3(grid), dim3(NWAVES * 64), LDS_BYTES, stream, a);

}
```

```cpp
#include <hip/hip_runtime.h>
#include <hip/hip_bf16.h>
#include <cstdio>
#include <cstdint>
#include <cmath>

__device__ __forceinline__ int tid_opaque() { int t = threadIdx.x; asm volatile("" : "+v"(t)); return t; }
namespace pg8 {
#define PG8_LAS __attribute__((address_space(3)))
typedef unsigned short bf16_t;
typedef short bf16x8 __attribute__((ext_vector_type(8)));
typedef float f32x4 __attribute__((ext_vector_type(4)));
typedef unsigned u32x4 __attribute__((ext_vector_type(4)));
typedef unsigned u32x2 __attribute__((ext_vector_type(2)));
constexpr int BM = 256, BK = 64, HALF = 128, HTB = HALF * BK * 2  , STAGE_BYTES = 8 * HTB, NXCD = 8, WGM = 8;

__host__ __device__ __forceinline__ int lds_byte(int r, int c) { const int st = (r >> 4) * 2 + (c >> 5), rr = r & 15, cc = c & 31, ob = rr * 64 + cc * 2; return st * 1024 + (ob ^ (((ob >> 9) & 1) << 5)); }
__host__ __device__ __forceinline__ void stage_rc(int b, int& R, int& C) { const int st = b / 1024, sb = b % 1024, swz = sb ^ (((sb >> 9) & 1) << 5); R = (st >> 1) * 16 + swz / 64; C = (st & 1) * 32 + (swz % 64) / 2; }
__host__ __device__ __forceinline__ int perm32(int rho) { const int n = rho >> 4, i = rho & 15; return 8 * (i >> 2) + 4 * n + (i & 3); }

struct Unit { int pm, pn, e, nrows, l0, kind; };

struct StaticOrder {
    int nM, nN, nwg, G, c;
    __host__ __device__ void init(int M, int N, int G_, int c_) { nM = M / BM; nN = N / BM; nwg = nM * nN; G = G_; c = c_; }
    __host__ __device__ bool next(int i, Unit& u) const {
        const long L = (long)i * G + c; if (L >= nwg) return false;
        int wgid = (int)L; { const int q = nwg / NXCD, r = nwg % NXCD, xcd = wgid % NXCD, off = wgid / NXCD; wgid = (xcd < r ? xcd * (q + 1) : r * (q + 1) + (xcd - r) * q) + off; }
        const int nig = WGM * nN, gid = wgid / nig, fm = gid * WGM, gsz = (nM - fm) < WGM ? (nM - fm) : WGM;
        u.pm = fm + ((wgid % nig) % gsz); u.pn = (wgid % nig) / gsz; u.e = 0; u.nrows = BM; u.l0 = 0; u.kind = 0; return true;
    }
};
__device__ __forceinline__ unsigned cvt_pk_bf16(float lo, float hi) { unsigned r; asm volatile("v_cvt_pk_bf16_f32 %0, %1, %2" : "=v"(r) : "v"(lo), "v"(hi)); return r; }

struct SrcDense {
    static constexpr bool VARIES = false;
    const bf16_t* A; const bf16_t* Bt; int K;
    __device__ __forceinline__ void setup(const Unit& u, const int (&Rr)[2], const int (&Cc)[2], const char*& aB, const char*& bB, unsigned (&vo)[2][2]) const {
        aB = (const char*)A + (size_t)u.pm * BM * K * 2; bB = (const char*)Bt + (size_t)u.pn * BM * K * 2;
#pragma unroll
        for (int h = 0; h < 2; ++h)
#pragma unroll
            for (int i = 0; i < 2; ++i) vo[h][i] = (unsigned)((h * HALF + Rr[i]) * K + Cc[i]) * 2u;
    }
};
template <class Epi, class Sched, class Src, bool ALIGN_EPI, bool SP2>
__device__ __forceinline__ void gemm_phase(PG8_LAS unsigned char* lds, const int K, const Sched& S, const Src& G, const Epi& E) {
    const int tid = tid_opaque(), wid = __builtin_amdgcn_readfirstlane(tid >> 6), lane = tid & 63, wr = wid >> 2, wc = wid & 3, fr = lane & 15, fq = lane >> 4;
    const int nt = K / BK;
    int Rr[2], Cc[2]; unsigned voffB[2];
#pragma unroll
    for (int i = 0; i < 2; ++i) { int R, C; stage_rc(tid * 16 + i * 8192, R, C); Rr[i] = R; Cc[i] = C; const int Rb = (R & ~31) + perm32(R & 31); voffB[i] = (unsigned)(Rb * K + C) * 2u; }
    const size_t kstep = (size_t)(BK * 2);
    const size_t hstep = (size_t)HALF * K * 2;
    const unsigned ldsw = (unsigned)wid * 1024u;
    const int aoff = lds_byte(wr * 64 + fr, fq * 8), boff = lds_byte(wc * 32 + fr, fq * 8);
#define PG8_SA(b, h) (((b) * 2 + (h)) * HTB)
#define PG8_SB(b, h) ((4 + (b) * 2 + (h)) * HTB)
#define PG8_STAGE(bufoff, gbase, voff) do { _Pragma("unroll") for (int _i = 0; _i < 2; ++_i) \
        __builtin_amdgcn_global_load_lds((const unsigned*)((const char*)(gbase) + (voff)[_i]), (PG8_LAS unsigned*)(lds + (bufoff) + ldsw + _i * 8192), 16, 0, 0); } while (0)
#define PG8_STA_C(bufoff, gbase, h) do { if constexpr (Src::VARIES) { PG8_STAGE(bufoff, gbase, vc[h]); } else { PG8_STAGE(bufoff, (gbase) + (h) * hstep, vc[0]); } } while (0)
#define PG8_STA_S(bufoff, gbase, h) do { if constexpr (Src::VARIES) { PG8_STAGE(bufoff, gbase, (h) ? s1 : s0); } else { PG8_STAGE(bufoff, (gbase) + (h) * hstep, vc[0]); } } while (0)
#define PG8_LDA(dst, b, h) do { _Pragma("unroll") for (int m = 0; m < 4; ++m) _Pragma("unroll") for (int k = 0; k < 2; ++k) dst[m][k] = *(const PG8_LAS bf16x8*)(lds + PG8_SA(b, h) + aoff + m * 2048 + k * 1024); } while (0)
#define PG8_LDB(dst, b, h) do { _Pragma("unroll") for (int n = 0; n < 2; ++n) _Pragma("unroll") for (int k = 0; k < 2; ++k) dst[n][k] = *(const PG8_LAS bf16x8*)(lds + PG8_SB(b, h) + boff + n * 2048 + k * 1024); } while (0)
#define PG8_MMA(ai, bj, At, Bt) do { __builtin_amdgcn_s_setprio(1); _Pragma("unroll") for (int m = 0; m < 4; ++m) _Pragma("unroll") for (int n = 0; n < 2; ++n) _Pragma("unroll") for (int k = 0; k < 2; ++k) \
        acc[ai][bj][m][n] = __builtin_amdgcn_mfma_f32_16x16x32_bf16(Bt[n][k], At[m][k], acc[ai][bj][m][n], 0, 0, 0); __builtin_amdgcn_s_setprio(0); } while (0)
#define PG8_WAIT_V(n) asm volatile("s_waitcnt vmcnt(" #n ")" ::: "memory")
#define PG8_WAIT_L(n) asm volatile("s_waitcnt lgkmcnt(" #n ")" ::: "memory")
#define PG8_BAR __builtin_amdgcn_s_barrier()
#define PG8_SCHED __builtin_amdgcn_sched_barrier(0)
    Unit cur, nxt; int ui = 0;
    if (!S.next(0, cur)) return;
    f32x4 acc[2][2][4][2];
#pragma unroll
    for (int a = 0; a < 2; ++a)
#pragma unroll
        for (int b = 0; b < 2; ++b)
#pragma unroll
            for (int m = 0; m < 4; ++m)
#pragma unroll
                for (int n = 0; n < 2; ++n) acc[a][b][m][n] = (f32x4){0.f, 0.f, 0.f, 0.f};
    bf16x8 At[4][2], B0[2][2], B1[2][2];
    const char *cA, *cB; unsigned vc[2][2];
    G.setup(cur, Rr, Cc, cA, cB, vc);
    if constexpr (SP2) {
        PG8_STAGE(PG8_SB(0, 0), cB, voffB); PG8_STAGE(PG8_SB(0, 1), cB + hstep, voffB); PG8_STA_C(PG8_SA(0, 0), cA, 0); PG8_STA_C(PG8_SA(0, 1), cA, 1);
        if (wr == 1) PG8_BAR;
        PG8_WAIT_V(2); PG8_BAR;
        PG8_STAGE(PG8_SB(1, 0), cB + kstep, voffB); PG8_STA_C(PG8_SA(1, 0), cA + kstep, 0); PG8_STAGE(PG8_SB(1, 1), cB + hstep + kstep, voffB);
        PG8_WAIT_V(6); PG8_BAR;
    } else {
        PG8_STAGE(PG8_SB(0, 0), cB, voffB); PG8_STA_C(PG8_SA(0, 0), cA, 0); PG8_STAGE(PG8_SB(0, 1), cB + hstep, voffB); PG8_STA_C(PG8_SA(0, 1), cA, 1);
        if (wr == 1) PG8_BAR;
        PG8_WAIT_V(4); PG8_BAR;
        PG8_STAGE(PG8_SB(1, 0), cB + kstep, voffB); PG8_STA_C(PG8_SA(1, 0), cA + kstep, 0); PG8_STAGE(PG8_SB(1, 1), cB + hstep + kstep, voffB);
        PG8_WAIT_V(6); PG8_BAR;
    }
    for (;;) {
        const bool has_next = S.next(ui + 1, nxt);
        const char *nA = cA, *nB = cB; unsigned vn[2][2] = {{vc[0][0], vc[0][1]}, {vc[1][0], vc[1][1]}};
        if (has_next) G.setup(nxt, Rr, Cc, nA, nB, vn);
        for (int t = 0; t < nt; t += 2) {
            const bool last = (t == nt - 2);
            const char* a1 = cA + (size_t)(t + 1) * kstep;
            const char* a2 = last ? nA : cA + (size_t)(t + 2) * kstep; const char* b2 = last ? nB : cB + (size_t)(t + 2) * kstep;
            const char* a3 = a2 + kstep; const char* b3 = b2 + kstep;
            const unsigned s0[2] = {last ? vn[0][0] : vc[0][0], last ? vn[0][1] : vc[0][1]}, s1[2] = {last ? vn[1][0] : vc[1][0], last ? vn[1][1] : vc[1][1]};
            if constexpr (SP2) {
            PG8_LDB(B0, 0, 0); PG8_LDB(B1, 0, 1); PG8_SCHED; PG8_LDA(At, 0, 0); PG8_STA_C(PG8_SA(1, 1), a1, 1);
            PG8_WAIT_V(8); PG8_WAIT_L(0); PG8_BAR; PG8_MMA(0, 0, At, B0); PG8_MMA(0, 1, At, B1); PG8_BAR; PG8_SCHED;
            PG8_LDA(At, 0, 1); PG8_STAGE(PG8_SB(0, 0), b2, voffB); PG8_STAGE(PG8_SB(0, 1), b2 + hstep, voffB); PG8_STA_S(PG8_SA(0, 0), a2, 0);
            PG8_WAIT_V(8); PG8_WAIT_L(0); PG8_BAR; PG8_MMA(1, 0, At, B0); PG8_MMA(1, 1, At, B1); PG8_BAR; PG8_SCHED;
            PG8_LDB(B0, 1, 0); PG8_LDB(B1, 1, 1); PG8_SCHED; PG8_LDA(At, 1, 0); PG8_STA_S(PG8_SA(0, 1), a2, 1);
            PG8_WAIT_V(8); PG8_WAIT_L(0); PG8_BAR; PG8_MMA(0, 0, At, B0); PG8_MMA(0, 1, At, B1); PG8_BAR; PG8_SCHED;
            PG8_LDA(At, 1, 1); PG8_STAGE(PG8_SB(1, 0), b3, voffB); PG8_STAGE(PG8_SB(1, 1), b3 + hstep, voffB); PG8_STA_S(PG8_SA(1, 0), a3, 0);
            PG8_WAIT_V(8); PG8_WAIT_L(0); PG8_BAR; PG8_MMA(1, 0, At, B0); PG8_MMA(1, 1, At, B1); PG8_BAR; PG8_SCHED;
            } else {
            PG8_LDB(B0, 0, 0); PG8_SCHED; PG8_LDA(At, 0, 0); PG8_STA_C(PG8_SA(1, 1), a1, 1);
            PG8_WAIT_L(8); PG8_BAR; PG8_WAIT_L(0); PG8_MMA(0, 0, At, B0); PG8_BAR; PG8_SCHED;
            PG8_LDB(B1, 0, 1); PG8_STAGE(PG8_SB(0, 0), b2, voffB);
            PG8_BAR; PG8_WAIT_L(0); PG8_MMA(0, 1, At, B1); PG8_BAR;
            PG8_LDA(At, 0, 1); PG8_STA_S(PG8_SA(0, 0), a2, 0);
            PG8_BAR; PG8_WAIT_L(0); PG8_MMA(1, 0, At, B0); PG8_BAR; PG8_SCHED;
            PG8_STAGE(PG8_SB(0, 1), b2 + hstep, voffB);
            PG8_WAIT_V(6); PG8_BAR; PG8_MMA(1, 1, At, B1); PG8_BAR;
            PG8_LDB(B0, 1, 0); PG8_SCHED; PG8_LDA(At, 1, 0); PG8_STA_S(PG8_SA(0, 1), a2, 1);
            PG8_WAIT_L(8); PG8_BAR; PG8_WAIT_L(0); PG8_MMA(0, 0, At, B0); PG8_BAR; PG8_SCHED;
            PG8_LDB(B1, 1, 1); PG8_STAGE(PG8_SB(1, 0), b3, voffB);
            PG8_BAR; PG8_WAIT_L(0); PG8_MMA(0, 1, At, B1); PG8_BAR;
            PG8_LDA(At, 1, 1); PG8_STA_S(PG8_SA(1, 0), a3, 0);
            PG8_BAR; PG8_WAIT_L(0); PG8_MMA(1, 0, At, B0); PG8_BAR; PG8_SCHED;
            PG8_STAGE(PG8_SB(1, 1), b3 + hstep, voffB);
            PG8_WAIT_V(6); PG8_BAR; PG8_MMA(1, 1, At, B1); PG8_BAR;
            }
        }
        if constexpr (ALIGN_EPI) { if (wr == 0) PG8_BAR; }
        { const int l2_ = tid_opaque() & 63; E(acc, cur, wr, wc, l2_ & 15, l2_ >> 4); }
        if (!has_next) break;
#pragma unroll
        for (int a = 0; a < 2; ++a)
#pragma unroll
            for (int b = 0; b < 2; ++b)
#pragma unroll
                for (int m = 0; m < 4; ++m)
#pragma unroll
                    for (int n = 0; n < 2; ++n) acc[a][b][m][n] = (f32x4){0.f, 0.f, 0.f, 0.f};
        cur = nxt; cA = nA; cB = nB; ++ui;
#pragma unroll
        for (int h = 0; h < 2; ++h)
#pragma unroll
            for (int i = 0; i < 2; ++i) vc[h][i] = vn[h][i];
        if constexpr (ALIGN_EPI) { if (wr == 1) PG8_BAR; }
    }
    PG8_WAIT_V(0);
    if constexpr (!ALIGN_EPI) { if (wr == 0) PG8_BAR; }
    PG8_BAR;
#undef PG8_SA
#undef PG8_SB
#undef PG8_STAGE
#undef PG8_STA_C
#undef PG8_STA_S
#undef PG8_LDA
#undef PG8_LDB
#undef PG8_MMA
#undef PG8_WAIT_V
#undef PG8_WAIT_L
#undef PG8_BAR
#undef PG8_SCHED
}

__device__ __forceinline__ float bf_lo(unsigned w) { return __uint_as_float(w << 16); }
__device__ __forceinline__ float bf_hi(unsigned w) { return __uint_as_float(w & 0xffff0000u); }
__device__ __forceinline__ u32x4 pack8(const f32x4 a, const f32x4 b) { u32x4 w; w.x = cvt_pk_bf16(a[0], a[1]); w.y = cvt_pk_bf16(a[2], a[3]); w.z = cvt_pk_bf16(b[0], b[1]); w.w = cvt_pk_bf16(b[2], b[3]); return w; }

__device__ __forceinline__ void store16_sc1(void* p, u32x4 v) { asm volatile("global_store_dwordx4 %0, %1, off sc1\n\ts_nop 1" :: "v"(p), "v"(v) : "memory"); }
struct EpiQKV {
    bf16_t* O; const float* gains; const float* rope; float c2;
    __device__ __forceinline__ void operator()(const f32x4 (&acc)[2][2][4][2], const Unit& u, int wr, int wc, int fr, int fq) const {
        const int kind = u.pn >> 1;
        const bool isv = (kind == 2) || (kind == 5), roped = kind < 2;
        const float* g = gains + (kind < 2 ? kind : (kind == 3 ? 2 : 3)) * 64;
        const float post = (kind == 0 || kind == 3) ? c2 : 1.f;
        f32x4 gv[2][2];
#pragma unroll
        for (int bj = 0; bj < 2; ++bj)
#pragma unroll
            for (int n = 0; n < 2; ++n) gv[bj][n] = isv ? (f32x4){1.f, 1.f, 1.f, 1.f} : *(const f32x4*)(g + 32 * bj + 8 * fq + 4 * n);
        const int row0 = u.pm * BM + wr * 64 + fr;
        bf16_t* colp = O + u.pn * 256 + wc * 64 + 8 * fq;
#pragma unroll
        for (int ai = 0; ai < 2; ++ai)
#pragma unroll
            for (int m = 0; m < 4; ++m) {
                const int row = row0 + ai * HALF + m * 16;
                f32x4 v[2][2];
#pragma unroll
                for (int bj = 0; bj < 2; ++bj)
#pragma unroll
                    for (int n = 0; n < 2; ++n) v[bj][n] = acc[ai][bj][m][n];
                if (!isv) {
                    float ss = 0.f;
#pragma unroll
                    for (int bj = 0; bj < 2; ++bj)
#pragma unroll
                        for (int n = 0; n < 2; ++n) { const f32x4 x = v[bj][n]; ss += (x[0] * x[0] + x[1] * x[1]) + (x[2] * x[2] + x[3] * x[3]); }
                    ss += __shfl_xor(ss, 16); ss += __shfl_xor(ss, 32);
                    const float r = 1.0f / sqrtf(ss * (1.0f / 64.0f) + 1e-6f);
#pragma unroll
                    for (int bj = 0; bj < 2; ++bj)
#pragma unroll
                        for (int n = 0; n < 2; ++n) v[bj][n] = v[bj][n] * r * gv[bj][n];
                    if (roped) {
#pragma unroll
                        for (int n = 0; n < 2; ++n) {
                            const f32x4 cs = *(const f32x4*)(rope + (size_t)row * 16 + 4 * n), sn = *(const f32x4*)(rope + (size_t)row * 16 + 8 + 4 * n);
                            const f32x4 mine = v[0][n]; f32x4 oth;
#pragma unroll
                            for (int i = 0; i < 4; ++i) oth[i] = __shfl_xor(mine[i], 16);
                            const f32x4 rot = (fq == 0) ? (mine * cs - oth * sn) : (mine * cs + oth * sn);
                            if (fq < 2) v[0][n] = rot;
                        }
                    }
#pragma unroll
                    for (int bj = 0; bj < 2; ++bj)
#pragma unroll
                        for (int n = 0; n < 2; ++n) v[bj][n] = v[bj][n] * post;
                }
#pragma unroll
                for (int bj = 0; bj < 2; ++bj) *(u32x4*)(colp + (size_t)row * 3072 + 32 * bj) = pack8(v[bj][0], v[bj][1]);
            }
    }
};
struct EpiBf16 {
    bf16_t* O; int ldc;
    __device__ __forceinline__ void operator()(const f32x4 (&acc)[2][2][4][2], const Unit& u, int wr, int wc, int fr, int fq) const {
        const int row0 = u.pm * BM + wr * 64 + fr, col0 = u.pn * BM + wc * 32 + 8 * fq;
#pragma unroll
        for (int ai = 0; ai < 2; ++ai)
#pragma unroll
            for (int m = 0; m < 4; ++m) { bf16_t* rowp = O + (size_t)(row0 + ai * HALF + m * 16) * ldc + col0;
#pragma unroll
                for (int bj = 0; bj < 2; ++bj) *(u32x4*)(rowp + bj * HALF) = pack8(acc[ai][bj][m][0], acc[ai][bj][m][1]); }
    }
};
struct EpiRes {
    const float* x; float* h1; bf16_t* hg; const float* g;
    __device__ __forceinline__ void operator()(const f32x4 (&acc)[2][2][4][2], const Unit& u, int wr, int wc, int fr, int fq) const {
        const int row0 = u.pm * BM + wr * 64 + fr, col0 = u.pn * BM + wc * 32 + 8 * fq;
        f32x4 gv[2][2];
#pragma unroll
        for (int bj = 0; bj < 2; ++bj)
#pragma unroll
            for (int n = 0; n < 2; ++n) gv[bj][n] = *(const f32x4*)(g + col0 + bj * HALF + 4 * n);
#pragma unroll
        for (int ai = 0; ai < 2; ++ai) {
            f32x4 xv[4][2][2];
#pragma unroll
            for (int m = 0; m < 4; ++m) { const size_t off = (size_t)(row0 + ai * HALF + m * 16) * 1024 + col0;
#pragma unroll
                for (int bj = 0; bj < 2; ++bj)
#pragma unroll
                    for (int n = 0; n < 2; ++n) xv[m][bj][n] = *(const f32x4*)(x + off + bj * HALF + 4 * n); }
#pragma unroll
            for (int m = 0; m < 4; ++m) { const size_t off = (size_t)(row0 + ai * HALF + m * 16) * 1024 + col0;
#pragma unroll
                for (int bj = 0; bj < 2; ++bj) {
                    const f32x4 h0 = xv[m][bj][0] + acc[ai][bj][m][0], h1v = xv[m][bj][1] + acc[ai][bj][m][1];
                    *(f32x4*)(h1 + off + bj * HALF) = h0; *(f32x4*)(h1 + off + bj * HALF + 4) = h1v;
                    *(u32x4*)(hg + off + bj * HALF) = pack8(h0 * gv[bj][0], h1v * gv[bj][1]); } }
            asm volatile("" ::: "memory"); }
    }
};
template <bool SC1> struct EpiSwigluT {
    bf16_t* hid; const float* listr; int T; const volatile PG8_LAS int* cnt;
    __device__ __forceinline__ void operator()(const f32x4 (&acc)[2][2][4][2], const Unit& u, int wr, int wc, int fr, int fq) const {
        const int last = __builtin_amdgcn_readfirstlane(cnt[u.e]) - 1;
#pragma unroll
        for (int ai = 0; ai < 2; ++ai)
#pragma unroll
            for (int m = 0; m < 4; ++m) {
                const int r = ai * HALF + wr * 64 + m * 16 + fr; int li = u.l0 + r; li = li < last ? li : last;
                const float rs = listr[(size_t)u.e * T + li];
                f32x4 hv[2];
#pragma unroll
                for (int n = 0; n < 2; ++n) { const f32x4 a = acc[ai][0][m][n] * rs, b = acc[ai][1][m][n] * rs;
#pragma unroll
                    for (int i = 0; i < 4; ++i) hv[n][i] = a[i] * __builtin_amdgcn_rcpf(1.0f + __builtin_amdgcn_exp2f(-1.4426950408889634f * a[i])) * b[i]; }
                bf16_t* dp = hid + (size_t)(u.pm * BM + r) * 512 + u.pn * 128 + wc * 32 + 8 * fq;
                if constexpr (SC1) store16_sc1(dp, pack8(hv[0], hv[1])); else *(u32x4*)dp = pack8(hv[0], hv[1]);
            }
    }
};
typedef EpiSwigluT<false> EpiSwiglu;
struct EpiDown {
    bf16_t* yb; const float* listw; int T; const volatile PG8_LAS int* cnt;
    __device__ __forceinline__ void operator()(const f32x4 (&acc)[2][2][4][2], const Unit& u, int wr, int wc, int fr, int fq) const {
        const int last = __builtin_amdgcn_readfirstlane(cnt[u.e]) - 1, col0 = u.pn * BM + wc * 32 + 8 * fq;
#pragma unroll
        for (int ai = 0; ai < 2; ++ai)
#pragma unroll
            for (int m = 0; m < 4; ++m) {
                const int r = ai * HALF + wr * 64 + m * 16 + fr; int li = u.l0 + r; li = li < last ? li : last;
                const float w = listw[(size_t)u.e * T + li];
                bf16_t* rowp = yb + (size_t)(u.pm * BM + r) * 1024 + col0;
#pragma unroll
                for (int bj = 0; bj < 2; ++bj) *(u32x4*)(rowp + bj * HALF) = pack8(acc[ai][bj][m][0] * w, acc[ai][bj][m][1] * w);
            }
    }
};
struct EpiFinal {
    float* out; const bf16_t* pleb; const bf16_t* h2b;
    __device__ __forceinline__ void operator()(const f32x4 (&acc)[2][2][4][2], const Unit& u, int wr, int wc, int fr, int fq) const {
        const int row0 = u.pm * BM + wr * 64 + fr, col0 = u.pn * BM + wc * 32 + 8 * fq;
#pragma unroll
        for (int ai = 0; ai < 2; ++ai)
#pragma unroll
          for (int mh = 0; mh < 2; ++mh) {
            u32x4 hw[2][2]; u32x4 pw[2][2];
#pragma unroll
            for (int mm = 0; mm < 2; ++mm) { const size_t off = (size_t)(row0 + ai * HALF + (2 * mh + mm) * 16) * 1024 + col0;
#pragma unroll
                for (int bj = 0; bj < 2; ++bj) { pw[mm][bj] = *(const u32x4*)(pleb + off + bj * HALF); hw[mm][bj] = *(const u32x4*)(h2b + off + bj * HALF); } }
#pragma unroll
            for (int mm = 0; mm < 2; ++mm) { const int m = 2 * mh + mm; const size_t off = (size_t)(row0 + ai * HALF + m * 16) * 1024 + col0;
#pragma unroll
                for (int bj = 0; bj < 2; ++bj) {
                    const u32x4 w = pw[mm][bj], hq = hw[mm][bj];
                    const f32x4 h0 = (f32x4){bf_lo(hq.x), bf_hi(hq.x), bf_lo(hq.y), bf_hi(hq.y)}, h1 = (f32x4){bf_lo(hq.z), bf_hi(hq.z), bf_lo(hq.w), bf_hi(hq.w)};
                    const f32x4 p0 = (f32x4){bf_lo(w.x), bf_hi(w.x), bf_lo(w.y), bf_hi(w.y)}, p1 = (f32x4){bf_lo(w.z), bf_hi(w.z), bf_lo(w.w), bf_hi(w.w)};
                    f32x4 g0, g1;
#pragma unroll
                    for (int i = 0; i < 4; ++i) { g0[i] = __builtin_amdgcn_rcpf(1.0f + __builtin_amdgcn_exp2f(-1.4426950408889634f * acc[ai][bj][m][0][i]));
                                                  g1[i] = __builtin_amdgcn_rcpf(1.0f + __builtin_amdgcn_exp2f(-1.4426950408889634f * acc[ai][bj][m][1][i])); }
                    *(f32x4*)(out + off + bj * HALF) = h0 + g0 * p0; *(f32x4*)(out + off + bj * HALF + 4) = h1 + g1 * p1; } }
            asm volatile("" ::: "memory"); }
    }
};
}

namespace pg8 {
struct MoeArgs { const bf16_t* HG; const bf16_t* Wup; bf16_t* HID; const bf16_t* Wdn; bf16_t* YB; const int* list; const float* listr; const float* listw;
                 unsigned* qctr; unsigned* done; unsigned* err; const volatile PG8_LAS int* tpre; const volatile PG8_LAS int* cnt; volatile PG8_LAS int* slot; int T, q0; };
__device__ __forceinline__ int moe_qlimit(const MoeArgs& M, int x) { return 8 * (M.tpre[4 * x + 4] - M.tpre[4 * x]); }
__device__ __forceinline__ int moe_fetch_sync(const MoeArgs& M, int& qx, int& tries) {
    while (tries < 8) {
        const int L = (int)__hip_atomic_fetch_add(M.qctr + 64 * qx, 1u, __ATOMIC_RELAXED, __HIP_MEMORY_SCOPE_AGENT);
        if (L < moe_qlimit(M, qx)) return (qx << 24) | L;
        qx = (qx + 1) & 7; ++tries;
    }
    return -1;
}
__device__ __forceinline__ void moe_decode(const MoeArgs& M, int gid, Unit& u) {
    const int x = gid >> 24, L = gid & 0xffffff, t0 = __builtin_amdgcn_readfirstlane(M.tpre[4 * x]), NU = 4 * (__builtin_amdgcn_readfirstlane(M.tpre[4 * x + 4]) - t0);
    u.kind = L >= NU ? 1 : 0; const int l = L - u.kind * NU, mt = t0 + (l >> 2); u.pn = l & 3; u.pm = mt;
    int e = 4 * x;
#pragma unroll
    for (int s = 1; s < 4; ++s) if (__builtin_amdgcn_readfirstlane(M.tpre[4 * x + s]) <= mt) e = 4 * x + s;
    u.e = e; u.l0 = (mt - __builtin_amdgcn_readfirstlane(M.tpre[e])) * BM; const int rem = __builtin_amdgcn_readfirstlane(M.cnt[e]) - u.l0; u.nrows = rem < BM ? rem : BM;
}
__device__ __forceinline__ void moe_setup(const MoeArgs& M, const Unit& u, int tid, const char*& aB, const char*& bB, unsigned (&vo)[2][2]) {
    int Rr[2], Cc[2];
#pragma unroll
    for (int i = 0; i < 2; ++i) stage_rc(tid * 16 + i * 8192, Rr[i], Cc[i]);
    if (u.kind == 0) {
        aB = (const char*)M.HG; bB = (const char*)M.Wup + ((size_t)u.e * 1024 + (size_t)u.pn * BM) * 1024 * 2;
        const int last = __builtin_amdgcn_readfirstlane(M.cnt[u.e]) - 1;
#pragma unroll
        for (int h = 0; h < 2; ++h)
#pragma unroll
            for (int i = 0; i < 2; ++i) { int li = u.l0 + h * HALF + Rr[i]; li = li < last ? li : last; const int tok = M.list[(size_t)u.e * M.T + li] >> 1; vo[h][i] = (unsigned)(tok * 1024 + Cc[i]) * 2u; }
    } else {
        aB = (const char*)M.HID + (size_t)u.pm * BM * 512 * 2; bB = (const char*)M.Wdn + ((size_t)u.e * 1024 + (size_t)u.pn * BM) * 512 * 2;
#pragma unroll
        for (int h = 0; h < 2; ++h)
#pragma unroll
            for (int i = 0; i < 2; ++i) vo[h][i] = (unsigned)((h * HALF + Rr[i]) * 512 + Cc[i]) * 2u;
    }
}
__device__ __forceinline__ void moe_wait_ready(const MoeArgs& M, const Unit& u) {
    if (u.kind == 1) {
        unsigned sp = 0;
        while (__hip_atomic_load(M.done + u.pm, __ATOMIC_RELAXED, __HIP_MEMORY_SCOPE_AGENT) < 4u) { __builtin_amdgcn_s_sleep(2); if (++sp > (1u << 22)) { __hip_atomic_store(M.err, 1u, __ATOMIC_RELAXED, __HIP_MEMORY_SCOPE_AGENT); break; } }
        asm volatile("" ::: "memory");
    }
}
__device__ __forceinline__ void moe_phase(PG8_LAS unsigned char* lds, const MoeArgs& M) {
    const int tid = tid_opaque(), wid = __builtin_amdgcn_readfirstlane(tid >> 6), lane = tid & 63, wr = wid >> 2, wc = wid & 3, fr = lane & 15, fq = lane >> 4;
    unsigned vB1k[2];
#pragma unroll
    for (int i = 0; i < 2; ++i) { int R, C; stage_rc(tid * 16 + i * 8192, R, C); const int Rb = (R & ~31) + perm32(R & 31); vB1k[i] = (unsigned)(Rb * 1024 + C) * 2u; }
#define VB512(i) ((vB1k[i] >> 1) + ((vB1k[i] & 2047u) >> 1))
    const size_t kstep = (size_t)(BK * 2);
    const unsigned ldsw = (unsigned)wid * 1024u;
    const int aoff = lds_byte(wr * 64 + fr, fq * 8), boff = lds_byte(wc * 32 + fr, fq * 8);
#define PG8_SA(b, h) (((b) * 2 + (h)) * HTB)
#define PG8_SB(b, h) ((4 + (b) * 2 + (h)) * HTB)
#define PG8_STAGE(bufoff, gbase, voff) do { _Pragma("unroll") for (int _i = 0; _i < 2; ++_i) \
        __builtin_amdgcn_global_load_lds((const unsigned*)((const char*)(gbase) + (voff)[_i]), (PG8_LAS unsigned*)(lds + (bufoff) + ldsw + _i * 8192), 16, 0, 0); } while (0)
#define PG8_LDA(dst, b, h) do { _Pragma("unroll") for (int m = 0; m < 4; ++m) _Pragma("unroll") for (int k = 0; k < 2; ++k) dst[m][k] = *(const PG8_LAS bf16x8*)(lds + PG8_SA(b, h) + aoff + m * 2048 + k * 1024); } while (0)
#define PG8_LDB(dst, b, h) do { _Pragma("unroll") for (int n = 0; n < 2; ++n) _Pragma("unroll") for (int k = 0; k < 2; ++k) dst[n][k] = *(const PG8_LAS bf16x8*)(lds + PG8_SB(b, h) + boff + n * 2048 + k * 1024); } while (0)
#define PG8_MMA(ai, bj, At, Bt) do { __builtin_amdgcn_s_setprio(1); _Pragma("unroll") for (int m = 0; m < 4; ++m) _Pragma("unroll") for (int n = 0; n < 2; ++n) _Pragma("unroll") for (int k = 0; k < 2; ++k) \
        acc[ai][bj][m][n] = __builtin_amdgcn_mfma_f32_16x16x32_bf16(Bt[n][k], At[m][k], acc[ai][bj][m][n], 0, 0, 0); __builtin_amdgcn_s_setprio(0); } while (0)
#define PG8_WAIT_V(n) asm volatile("s_waitcnt vmcnt(" #n ")" ::: "memory")
#define PG8_WAIT_L(n) asm volatile("s_waitcnt lgkmcnt(" #n ")" ::: "memory")
#define PG8_BAR __builtin_amdgcn_s_barrier()
#define PG8_SCHED __builtin_amdgcn_sched_barrier(0)
    Unit cur, nxt; int ui = 0;
    int qx = M.q0, tries = 0;
    if (tid == 0) { M.slot[0] = moe_fetch_sync(M, qx, tries); M.slot[1] = moe_fetch_sync(M, qx, tries); }
    asm volatile("s_waitcnt lgkmcnt(0)\n\ts_barrier" ::: "memory");
    { const int g0 = __builtin_amdgcn_readfirstlane(M.slot[0]); if (g0 < 0) return; moe_decode(M, g0, cur); }
    f32x4 acc[2][2][4][2];
#pragma unroll
    for (int a = 0; a < 2; ++a)
#pragma unroll
        for (int b = 0; b < 2; ++b)
#pragma unroll
            for (int m = 0; m < 4; ++m)
#pragma unroll
                for (int n = 0; n < 2; ++n) acc[a][b][m][n] = (f32x4){0.f, 0.f, 0.f, 0.f};
    bf16x8 At[4][2], B0[2][2], B1[2][2];
    const char *cA, *cB; unsigned vc[2][2];
    for (;;) {
    moe_wait_ready(M, cur);
    moe_setup(M, cur, tid, cA, cB, vc);
    {   const size_t hs = cur.kind ? (size_t)HALF * 512 * 2 : (size_t)HALF * 1024 * 2; const unsigned vb[2] = {cur.kind ? VB512(0) : vB1k[0], cur.kind ? VB512(1) : vB1k[1]};
        PG8_STAGE(PG8_SB(0, 0), cB, vb); PG8_STAGE(PG8_SB(0, 1), cB + hs, vb); PG8_STAGE(PG8_SA(0, 0), cA, vc[0]); PG8_STAGE(PG8_SA(0, 1), cA, vc[1]);
        if (wr == 1) PG8_BAR;
        PG8_WAIT_V(2); PG8_BAR;
        PG8_STAGE(PG8_SB(1, 0), cB + kstep, vb); PG8_STAGE(PG8_SA(1, 0), cA + kstep, vc[0]); PG8_STAGE(PG8_SB(1, 1), cB + hs + kstep, vb);
        PG8_WAIT_V(6); PG8_BAR; }
    bool stop = false;
    for (;;) {
        const int gnx = __builtin_amdgcn_readfirstlane(M.slot[(ui + 1) & 1]); const bool has_next = gnx >= 0;
        if (has_next) moe_decode(M, gnx, nxt);
        int pend = 0x7fffffff;
        if (tid == 0 && tries < 8) pend = (int)__hip_atomic_fetch_add(M.qctr + 64 * qx, 1u, __ATOMIC_RELAXED, __HIP_MEMORY_SCOPE_AGENT);
        const char *nA = cA, *nB = cB; unsigned vn[2][2] = {{vc[0][0], vc[0][1]}, {vc[1][0], vc[1][1]}};
        if (has_next) moe_setup(M, nxt, tid, nA, nB, vn);
        const int nt = cur.kind ? 8 : 16;
        const size_t hsC = cur.kind ? (size_t)HALF * 512 * 2 : (size_t)HALF * 1024 * 2;
        bool chain = has_next;
        for (int t = 0; t < nt; t += 2) {
            const bool last = (t == nt - 2);
            if (t == nt - 4 && has_next && nxt.kind == 1 && tid == 0) M.slot[2] = (__hip_atomic_load(M.done + nxt.pm, __ATOMIC_RELAXED, __HIP_MEMORY_SCOPE_AGENT) >= 4u) ? 1 : 0;
            if (last && has_next && nxt.kind == 1) {
                if (__builtin_amdgcn_readfirstlane(M.slot[2]) == 0) { if (cur.kind == 1) moe_wait_ready(M, nxt); else chain = false; }
            }
            const int nk = chain ? nxt.kind : cur.kind;
            const size_t hsN = nk ? (size_t)HALF * 512 * 2 : (size_t)HALF * 1024 * 2;
            const bool usen = last && chain;
            const char* a1 = cA + (size_t)(t + 1) * kstep;
            const char* a2 = usen ? nA : (last ? cA : cA + (size_t)(t + 2) * kstep); const char* b2 = usen ? nB : (last ? cB : cB + (size_t)(t + 2) * kstep);
            const char* a3 = a2 + kstep; const char* b3 = b2 + kstep;
            const unsigned s0[2] = {usen ? vn[0][0] : vc[0][0], usen ? vn[0][1] : vc[0][1]}, s1[2] = {usen ? vn[1][0] : vc[1][0], usen ? vn[1][1] : vc[1][1]};
            const int k2 = last ? nk : cur.kind; const size_t hs2 = last ? hsN : hsC;
            const unsigned vb2[2] = {k2 ? VB512(0) : vB1k[0], k2 ? VB512(1) : vB1k[1]};
            PG8_LDB(B0, 0, 0); PG8_LDB(B1, 0, 1); PG8_SCHED; PG8_LDA(At, 0, 0); PG8_STAGE(PG8_SA(1, 1), a1, vc[1]);
            PG8_WAIT_V(8); PG8_WAIT_L(0); PG8_BAR; PG8_MMA(0, 0, At, B0); PG8_MMA(0, 1, At, B1); PG8_BAR; PG8_SCHED;
            PG8_LDA(At, 0, 1); PG8_STAGE(PG8_SB(0, 0), b2, vb2); PG8_STAGE(PG8_SB(0, 1), b2 + hs2, vb2); PG8_STAGE(PG8_SA(0, 0), a2, s0);
            PG8_WAIT_V(8); PG8_WAIT_L(0); PG8_BAR; PG8_MMA(1, 0, At, B0); PG8_MMA(1, 1, At, B1); PG8_BAR; PG8_SCHED;
            PG8_LDB(B0, 1, 0); PG8_LDB(B1, 1, 1); PG8_SCHED; PG8_LDA(At, 1, 0); PG8_STAGE(PG8_SA(0, 1), a2, s1);
            PG8_WAIT_V(8); PG8_WAIT_L(0); PG8_BAR; PG8_MMA(0, 0, At, B0); PG8_MMA(0, 1, At, B1); PG8_BAR; PG8_SCHED;
            PG8_LDA(At, 1, 1); PG8_STAGE(PG8_SB(1, 0), b3, vb2); PG8_STAGE(PG8_SB(1, 1), b3 + hs2, vb2); PG8_STAGE(PG8_SA(1, 0), a3, s0);
            PG8_WAIT_V(8); PG8_WAIT_L(0); PG8_BAR; PG8_MMA(1, 0, At, B0); PG8_MMA(1, 1, At, B1); PG8_BAR; PG8_SCHED;
        }
        if (wr == 0) PG8_BAR;
        if (cur.kind == 0) {
            EpiSwigluT<true> E{M.HID, M.listr, M.T, M.cnt}; { const int l2_ = tid_opaque() & 63; E(acc, cur, wr, wc, l2_ & 15, l2_ >> 4); }
            asm volatile("s_waitcnt vmcnt(0)" ::: "memory");
        } else {
            EpiDown E{M.YB, M.listw, M.T, M.cnt}; { const int l2_ = tid_opaque() & 63; E(acc, cur, wr, wc, l2_ & 15, l2_ >> 4); }
        }
        if (tid == 0) {
            int g2 = -1;
            if (tries < 8) { if (pend < moe_qlimit(M, qx)) g2 = (qx << 24) | pend; else { qx = (qx + 1) & 7; ++tries; g2 = moe_fetch_sync(M, qx, tries); } }
            M.slot[ui & 1] = g2;
        }
        asm volatile("s_waitcnt lgkmcnt(0)" ::: "memory");
        PG8_BAR;
        if (cur.kind == 0 && tid == 0) __hip_atomic_fetch_add(M.done + cur.pm, 1u, __ATOMIC_RELAXED, __HIP_MEMORY_SCOPE_AGENT);
        if (!has_next) { stop = true; break; }
#pragma unroll
        for (int a = 0; a < 2; ++a)
#pragma unroll
            for (int b = 0; b < 2; ++b)
#pragma unroll
                for (int m = 0; m < 4; ++m)
#pragma unroll
                    for (int n = 0; n < 2; ++n) acc[a][b][m][n] = (f32x4){0.f, 0.f, 0.f, 0.f};
        cur = nxt; ++ui;
        if (!chain) break;
        cA = nA; cB = nB;
#pragma unroll
        for (int h = 0; h < 2; ++h)
#pragma unroll
            for (int i = 0; i < 2; ++i) vc[h][i] = vn[h][i];
        if (wr == 1) PG8_BAR;
    }
    PG8_WAIT_V(0);
    PG8_BAR;
    if (stop) break;
    }
#undef VB512
#undef PG8_SA
#undef PG8_SB
#undef PG8_STAGE
#undef PG8_LDA
#undef PG8_LDB
#undef PG8_MMA
#undef PG8_WAIT_V
#undef PG8_WAIT_L
#undef PG8_BAR
#undef PG8_SCHED
}
}

namespace attn_body {
using bf16=__hip_bfloat16;
using bf16x8=__attribute__((ext_vector_type(8)))short;
using s16x4=__attribute__((ext_vector_type(4)))short;
using f32x16=__attribute__((ext_vector_type(16)))float;
using f32x4=__attribute__((ext_vector_type(4)))float;
using u32x4=__attribute__((ext_vector_type(4)))unsigned;
constexpr int BATCH=8,NHEAD=8,SEQ=2048,D=64,DMQ=3072,DMO=1024;
constexpr int NW=8,QBLK=32,QB=QBLK*NW,KVBLK=64,NQB=SEQ/QB;
__device__ __forceinline__ int crow(int r,int hi){return (r&3)+8*(r>>2)+4*hi;}
#define SBAR() __builtin_amdgcn_sched_barrier(0)
__device__ __forceinline__ void cmask(f32x16&p0,f32x16&p1,int jb,int qrel,int hi){
  const float NEG=-INFINITY; const int d=qrel-64*jb-4*hi;
  #pragma unroll
  for(int r=0;r<16;++r){const int k=(r&3)+8*(r>>2); if(k>d)p0[r]=NEG; if(k+32>d)p1[r]=NEG;}
}
constexpr int NSLOT=3, SLOTB=8192;
constexpr int LDS_K=0, LDS_V=NSLOT*SLOTB, LDS_WS=2*NSLOT*SLOTB, LDS_OST=LDS_WS+NW*64*4, LDS_BIAS=LDS_OST+NW*4096, LUT_OFF=256, LUT_N=SEQ+LUT_OFF, LDS_LUT=LDS_BIAS+SEQ*4, LDS_BYTES=LDS_LUT+LUT_N*4;
__device__ __forceinline__ void glds16(const void*gsrc,unsigned lds_dst){unsigned keep;
  asm volatile("s_mov_b32 %0, m0\n\ts_mov_b32 m0, %2\n\ts_nop 0\n\tglobal_load_lds_dwordx4 %1, off\n\ts_mov_b32 m0, %0":"=&s"(keep):"v"(gsrc),"s"(lds_dst):"memory");}
typedef float f32x2_t __attribute__((ext_vector_type(2))); typedef __bf16 bf16x2_t __attribute__((ext_vector_type(2)));
__device__ __forceinline__ unsigned cvtpk_s(float lo,float hi){f32x2_t v={lo,hi};bf16x2_t b=__builtin_convertvector(v,bf16x2_t);return __builtin_bit_cast(unsigned,b);}
#define WAIT_BAR(N) asm volatile("s_waitcnt vmcnt(" #N ") lgkmcnt(0)\n\ts_barrier":::"memory")
typedef __attribute__((address_space(3))) const char* lds_cptr;
typedef short v4i16_t __attribute__((ext_vector_type(4)));
__device__ __forceinline__ void kload8(bf16x8*kf,lds_cptr kp){
  kf[0]=*(const __attribute__((address_space(3))) bf16x8*)(kp);      kf[1]=*(const __attribute__((address_space(3))) bf16x8*)(kp+512);
  kf[2]=*(const __attribute__((address_space(3))) bf16x8*)(kp+2048); kf[3]=*(const __attribute__((address_space(3))) bf16x8*)(kp+2560);
  kf[4]=*(const __attribute__((address_space(3))) bf16x8*)(kp+4096); kf[5]=*(const __attribute__((address_space(3))) bf16x8*)(kp+4608);
  kf[6]=*(const __attribute__((address_space(3))) bf16x8*)(kp+6144); kf[7]=*(const __attribute__((address_space(3))) bf16x8*)(kp+6656);
}
__device__ __forceinline__ void kload2(bf16x8*kf,lds_cptr kp,int j){ kf[2*j]=*(const __attribute__((address_space(3))) bf16x8*)(kp+j*2048); kf[2*j+1]=*(const __attribute__((address_space(3))) bf16x8*)(kp+j*2048+512); }
__device__ __forceinline__ s16x4 vtr(lds_cptr p){ return __builtin_bit_cast(s16x4,__builtin_amdgcn_ds_read_tr16_b64_v4i16((__attribute__((address_space(3))) v4i16_t*)p)); }
__device__ __forceinline__ void pv(f32x16*o,int vb,bf16x8 pa0,bf16x8 pa1,bf16x8 pa2,bf16x8 pa3){
  #pragma unroll
  for(int d0=0;d0<2;++d0){s16x4 lo[4],hi[4];
    #pragma unroll
    for(int ks=0;ks<4;++ks){
      asm volatile("ds_read_b64_tr_b16 %0,%1 offset:%c2":"=&v"(lo[ks]):"v"(vb),"i"(d0*4096+ks*1024):"memory");
      asm volatile("ds_read_b64_tr_b16 %0,%1 offset:%c2":"=&v"(hi[ks]):"v"(vb),"i"(d0*4096+ks*1024+512):"memory");}
    asm volatile("s_waitcnt lgkmcnt(0)":::"memory");SBAR();
    #define PK(k) (bf16x8){lo[k][0],lo[k][1],lo[k][2],lo[k][3],hi[k][0],hi[k][1],hi[k][2],hi[k][3]}
    o[d0]=__builtin_amdgcn_mfma_f32_32x32x16_bf16(pa0,PK(0),o[d0],0,0,0);
    o[d0]=__builtin_amdgcn_mfma_f32_32x32x16_bf16(pa1,PK(1),o[d0],0,0,0);
    o[d0]=__builtin_amdgcn_mfma_f32_32x32x16_bf16(pa2,PK(2),o[d0],0,0,0);
    o[d0]=__builtin_amdgcn_mfma_f32_32x32x16_bf16(pa3,PK(3),o[d0],0,0,0);
    #undef PK
  }
}
template<int KIND> __device__ __forceinline__ void bias_tile(f32x16&c0,f32x16&c1,const __attribute__((address_space(3))) float*bl,int t,float cq,int dq,int hi){
  if constexpr(KIND==0){
    const __attribute__((address_space(3))) float*p=bl+64*t+4*hi;
    #pragma unroll
    for(int g=0;g<4;++g){ const f32x4 a=*(const __attribute__((address_space(3))) f32x4*)(p+8*g), b=*(const __attribute__((address_space(3))) f32x4*)(p+32+8*g);
      #pragma unroll
      for(int j=0;j<4;++j){c0[4*g+j]=cq-a[j];c1[4*g+j]=cq-b[j];} }
  } else {
    const __attribute__((address_space(3))) float*p=bl+(dq-64*t-4*hi);
    #pragma unroll
    for(int r=0;r<16;++r){ const int k=(r&3)+8*(r>>2); c0[r]=p[-k]; c1[r]=p[-k-32]; }
  }
}

__device__ __forceinline__ void next_ptrs(int kind,int b,int h,int qb,const bf16*QKV,const bf16*&nQ,const bf16*&nK){
  const int tid=tid_opaque(),lane=tid&63,r32=lane&31,hi=lane>>5; const int wid=__builtin_amdgcn_readfirstlane(tid>>6);
  const int QC=(kind==0)?1536:0, KC=QC+512; const long rowbase=(long)b*SEQ;
  nQ=QKV+(rowbase+qb*QB+wid*QBLK+r32)*DMQ+QC+h*D+hi*8;
  nK=QKV+(rowbase+lane)*DMQ+KC+h*D+wid*8;
}
template<int KIND> __device__ __forceinline__ void attn_unit(int b,int h,int qb,const bf16*QKV,const float*__restrict__ cumg,bf16*MIX,char*shm,const bool pre,bf16x8(&qio)[4],const bf16*nQ,const bf16*nK){
  const int tid=tid_opaque(),lane=tid&63,r32=lane&31,hi=lane>>5; const int wid=__builtin_amdgcn_readfirstlane(tid>>6);
  const long rowbase=(long)b*SEQ; const int q0=qb*QB;
  constexpr int QC=(KIND==0)?1536:0, KC=QC+512, VC=QC+1024, OC=(KIND==0)?512:0;
  const bf16*Qw=QKV+(rowbase+q0+wid*QBLK)*DMQ+QC+h*D;
  const bf16*Kh=QKV+rowbase*DMQ+KC+h*D,*Vh=QKV+rowbase*DMQ+VC+h*D;
  const unsigned lds0=(unsigned)(uintptr_t)shm;
  float*wsf=(float*)(shm+LDS_WS)+wid*64;
  const __attribute__((address_space(3))) float*bl=(const __attribute__((address_space(3))) float*)((lds_cptr)shm+((KIND==0)?LDS_BIAS:LDS_LUT));
  float cq=0.f; const int dq=q0+wid*QBLK+r32+LUT_OFF;
  if constexpr(KIND==0){
    const float*cg=cumg+((long)b*NHEAD+h)*SEQ;
    __attribute__((address_space(3))) float*bw=(__attribute__((address_space(3))) float*)((__attribute__((address_space(3))) char*)shm+LDS_BIAS);
    for(int i=tid;i<q0+QB;i+=NW*64)bw[i]=cg[i];
    cq=cg[q0+wid*QBLK+r32];
  }
  const bf16*ksrc=Kh+(long)lane*DMQ+wid*8;
  const bf16*vsrc=Vh+(long)(16*(wid&3)+(lane>>2))*DMQ+(wid>>2)*32+(lane&3)*8;
  const unsigned kdst=lds0+LDS_K+wid*1024, vdst=lds0+LDS_V+wid*1024;
  #define DMA_K(t,slot) glds16(ksrc+(long)(t)*KVBLK*DMQ,(unsigned)__builtin_amdgcn_readfirstlane(kdst+(slot)))
  #define DMA_V(t,slot) glds16(vsrc+(long)(t)*KVBLK*DMQ,(unsigned)__builtin_amdgcn_readfirstlane(vdst+(slot)))
  const int vb0=(int)(lds0+LDS_V)+((lane>>4)&1)*32+(lane&3)*8+(4*hi+((lane&15)>>2))*64;
  bf16x8 kf[8];
  const lds_cptr shm3=(lds_cptr)shm; const lds_cptr kp0=shm3+LDS_K+hi*1024+r32*16; const lds_cptr vp0=shm3+LDS_V+((lane>>4)&1)*32+(lane&3)*8+(4*hi+((lane&15)>>2))*64;
  const int NT=(q0+QB)/KVBLK;
  bf16x8 qr[4];
  if(pre){ DMA_V(0,0);
    #pragma unroll
    for(int d0=0;d0<4;++d0)qr[d0]=qio[d0];
  } else { DMA_K(0,0);DMA_V(0,0);DMA_K(1,SLOTB);
    #pragma unroll
    for(int d0=0;d0<4;++d0)qr[d0]=*reinterpret_cast<const bf16x8*>(&Qw[(long)r32*DMQ+d0*16+hi*8]); }
  float l_reg=0.f;f32x16 o[2];o[0]=f32x16{};o[1]=f32x16{};
  const int qrel=wid*QBLK+r32;
  #define CMASK(P0,P1,t) do{int jb_=(t)-(NT-4); if(jb_>=0)cmask(P0,P1,jb_,qrel,hi);}while(0)
  f32x16 pA0,pA1,pB0,pB1;
  int sl_prev=0,sl_cur=0,sl_next=SLOTB;
  #define ROT() do{sl_prev=sl_cur;sl_cur=sl_next;sl_next=(sl_next==(NSLOT-1)*SLOTB)?0:sl_next+SLOTB;}while(0)
  if(pre){ WAIT_BAR(1); }
  else { DMA_K(2,2*SLOTB);
  WAIT_BAR(3); }
  { f32x16 c0,c1; bias_tile<KIND>(c0,c1,bl,0,cq,dq,hi);
    const lds_cptr kb=kp0;
    #pragma unroll
    for(int d0=0;d0<4;++d0){
      const bf16x8 b0=*(const __attribute__((address_space(3))) bf16x8*)(kb+d0*2048);
      const bf16x8 b1=*(const __attribute__((address_space(3))) bf16x8*)(kb+d0*2048+512);
      if(d0==0){pA0=__builtin_amdgcn_mfma_f32_32x32x16_bf16(b0,qr[0],c0,0,0,0);pA1=__builtin_amdgcn_mfma_f32_32x32x16_bf16(b1,qr[0],c1,0,0,0);}
      else{pA0=__builtin_amdgcn_mfma_f32_32x32x16_bf16(b0,qr[d0],pA0,0,0,0);pA1=__builtin_amdgcn_mfma_f32_32x32x16_bf16(b1,qr[d0],pA1,0,0,0);}}
  }
  CMASK(pA0,pA1,0);
  _Pragma("unroll") for(int r=0;r<16;++r){pA0[r]=__builtin_amdgcn_exp2f(pA0[r]);pA1[r]=__builtin_amdgcn_exp2f(pA1[r]);}
  WAIT_BAR(0);
  DMA_K(3,0);DMA_V(1,SLOTB);
  ROT();
  kload8(kf,kp0+sl_cur);
  WAIT_BAR(2);
  s16x4 vlo[8],vhi[8]; u32x4 pw0,pw1,pw2,pw3;
  #define PKW(P,B) cvtpk_s(P[B],P[B+1])
  #define PAF(k) __builtin_bit_cast(bf16x8,pw##k)
  #define VFR(i) (bf16x8){vlo[i][0],vlo[i][1],vlo[i][2],vlo[i][3],vhi[i][0],vhi[i][1],vhi[i][2],vhi[i][3]}
  #define PIN(x) asm volatile("":"+v"(x))
  #define GAPA(MF,A0,A1,A2,A3,W0,W1,PW) do{ MF; sacc+=A0; sacc+=A1; sacc+=A2; sacc+=A3; PIN(sacc); W0; W1; PIN(PW); SBAR(); }while(0)
  #define EX(v) __builtin_amdgcn_exp2f(v)
  #define GAPB(MF,X,B) do{ MF; X[B]=EX(X[B]); X[B+1]=EX(X[B+1]); X[B+2]=EX(X[B+2]); X[B+3]=EX(X[B+3]); PIN(X); SBAR(); }while(0)
  #define VRD(i) do{ vlo[i]=vtr(vp_+(((i)>>2)*4096+((i)&3)*1024)); vhi[i]=vtr(vp_+(((i)>>2)*4096+((i)&3)*1024+512)); }while(0)
  #define KRD(G,j) do{ if(G){ kload2(kf,kp0+sl_next,j); SBAR(); } }while(0)
  #define STEP(C0,C1,P0,P1,t,GK,GV,GL) do{ SBAR(); \
    bias_tile<KIND>(C0,C1,bl,(t),cq,dq,hi); SBAR(); \
    const lds_cptr vp_=vp0+sl_prev; \
    VRD(0); SBAR(); float sacc=(P0[0]+P0[1]); \
    GAPA(C0=__builtin_amdgcn_mfma_f32_32x32x16_bf16(kf[0],qr[0],C0,0,0,0), P0[2],P0[3],P0[4],P0[5],     pw0[0]=PKW(P0,0), pw0[1]=PKW(P0,2), pw0); \
    VRD(4); SBAR(); GAPA(C1=__builtin_amdgcn_mfma_f32_32x32x16_bf16(kf[1],qr[0],C1,0,0,0), P0[6],P0[7],P0[8],P0[9],     pw0[2]=PKW(P0,4), pw0[3]=PKW(P0,6), pw0); \
    VRD(1); SBAR(); GAPA(C0=__builtin_amdgcn_mfma_f32_32x32x16_bf16(kf[2],qr[1],C0,0,0,0),   P0[10],P0[11],P0[12],P0[13], pw1[0]=PKW(P0,8), pw1[1]=PKW(P0,10), pw1); \
    VRD(5); SBAR(); GAPA(C1=__builtin_amdgcn_mfma_f32_32x32x16_bf16(kf[3],qr[1],C1,0,0,0),   P0[14],P0[15],P1[0],P1[1],   pw1[2]=PKW(P0,12),pw1[3]=PKW(P0,14), pw1); \
    VRD(2); SBAR(); GAPA(C0=__builtin_amdgcn_mfma_f32_32x32x16_bf16(kf[4],qr[2],C0,0,0,0),   P1[2],P1[3],P1[4],P1[5],     pw2[0]=PKW(P1,0), pw2[1]=PKW(P1,2), pw2); \
    VRD(6); SBAR(); GAPA(C1=__builtin_amdgcn_mfma_f32_32x32x16_bf16(kf[5],qr[2],C1,0,0,0),   P1[6],P1[7],P1[8],P1[9],     pw2[2]=PKW(P1,4), pw2[3]=PKW(P1,6), pw2); \
    VRD(3); SBAR(); GAPA(C0=__builtin_amdgcn_mfma_f32_32x32x16_bf16(kf[6],qr[3],C0,0,0,0),   P1[10],P1[11],P1[12],P1[13], pw3[0]=PKW(P1,8), pw3[1]=PKW(P1,10), pw3); \
    VRD(7); SBAR(); GAPA(C1=__builtin_amdgcn_mfma_f32_32x32x16_bf16(kf[7],qr[3],C1,0,0,0),   P1[14],P1[15],0.f,0.f,       pw3[2]=PKW(P1,12),pw3[3]=PKW(P1,14), pw3); \
    l_reg+=sacc; \
    if(GK){DMA_K((t)+3,sl_cur);} if(GV){DMA_V((t)+1,sl_next);} \
    CMASK(C0,C1,t); \
    SBAR(); \
    GAPB(o[0]=__builtin_amdgcn_mfma_f32_32x32x16_bf16(PAF(0),VFR(0),o[0],0,0,0), C0,0); \
    GAPB(o[1]=__builtin_amdgcn_mfma_f32_32x32x16_bf16(PAF(0),VFR(4),o[1],0,0,0), C0,4); \
    KRD(GL,0); GAPB(o[0]=__builtin_amdgcn_mfma_f32_32x32x16_bf16(PAF(1),VFR(1),o[0],0,0,0), C0,8); \
    KRD(GL,1); GAPB(o[1]=__builtin_amdgcn_mfma_f32_32x32x16_bf16(PAF(1),VFR(5),o[1],0,0,0), C0,12); \
    KRD(GL,2); GAPB(o[0]=__builtin_amdgcn_mfma_f32_32x32x16_bf16(PAF(2),VFR(2),o[0],0,0,0), C1,0); \
    KRD(GL,3); GAPB(o[1]=__builtin_amdgcn_mfma_f32_32x32x16_bf16(PAF(2),VFR(6),o[1],0,0,0), C1,4); \
    GAPB(o[0]=__builtin_amdgcn_mfma_f32_32x32x16_bf16(PAF(3),VFR(3),o[0],0,0,0), C1,8); \
    GAPB(o[1]=__builtin_amdgcn_mfma_f32_32x32x16_bf16(PAF(3),VFR(7),o[1],0,0,0), C1,12); \
    }while(0)
  int t=1;
  #undef CMASK
  #define CMASK(P0,P1,t) do{}while(0)
  for(;t+5<NT;t+=2){
    STEP(pB0,pB1,pA0,pA1,t,true,true,true);     WAIT_BAR(2); ROT();
    STEP(pA0,pA1,pB0,pB1,t+1,true,true,true);   WAIT_BAR(2); ROT();
  }
  #undef CMASK
  #define CMASK(P0,P1,t) do{int jb_=(t)-(NT-4); if(jb_>=0)cmask(P0,P1,jb_,qrel,hi);}while(0)
  #define ENDW(tt) do{ if((tt)+3<NT){WAIT_BAR(2);} else if((tt)+2<NT){WAIT_BAR(1);} else {WAIT_BAR(0);} }while(0)
  for(;t+1<NT;t+=2){
    STEP(pB0,pB1,pA0,pA1,t,(t+3<NT),(t+1<NT),(t+1<NT));       ENDW(t);   ROT();
    STEP(pA0,pA1,pB0,pB1,t+1,(t+4<NT),(t+2<NT),(t+2<NT));     ENDW(t+1); ROT();
  }
  if(nK){ glds16(nK,(unsigned)__builtin_amdgcn_readfirstlane(kdst)); glds16(nK+(long)KVBLK*DMQ,(unsigned)__builtin_amdgcn_readfirstlane(kdst+SLOTB)); glds16(nK+2L*KVBLK*DMQ,(unsigned)__builtin_amdgcn_readfirstlane(kdst+2*SLOTB)); }
  STEP(pB0,pB1,pA0,pA1,NT-1,false,false,false);
  { float sacc=pB0[0]+pB0[1]; _Pragma("unroll") for(int r=2;r<16;++r)sacc+=pB0[r]; _Pragma("unroll") for(int r=0;r<16;++r)sacc+=pB1[r]; l_reg+=sacc;
    pw0=(u32x4){PKW(pB0,0),PKW(pB0,2),PKW(pB0,4),PKW(pB0,6)};pw1=(u32x4){PKW(pB0,8),PKW(pB0,10),PKW(pB0,12),PKW(pB0,14)};pw2=(u32x4){PKW(pB1,0),PKW(pB1,2),PKW(pB1,4),PKW(pB1,6)};pw3=(u32x4){PKW(pB1,8),PKW(pB1,10),PKW(pB1,12),PKW(pB1,14)};
    SBAR(); pv(o,vb0+sl_cur,PAF(0),PAF(1),PAF(2),PAF(3)); }
  #undef PKW
  #undef PAF
  #undef VFR
  #undef PIN
  #undef GAPA
  #undef GAPB
  #undef EX
  #undef VRD
  #undef KRD
  #undef STEP
  #undef ENDW
  if(nQ){
    #pragma unroll
    for(int d0=0;d0<4;++d0)qio[d0]=*reinterpret_cast<const bf16x8*>(nQ+d0*16); }
  {auto rr=__builtin_amdgcn_permlane32_swap(__float_as_uint(l_reg),__float_as_uint(l_reg),false,false);l_reg=__uint_as_float(rr[0])+__uint_as_float(rr[1]);}
  if(hi==0)wsf[32+r32]=l_reg;asm volatile("s_waitcnt lgkmcnt(0)":::"memory");
  float rli[16];
  #pragma unroll
  for(int r=0;r<16;++r)rli[r]=__builtin_amdgcn_rcpf(wsf[32+crow(r,hi)]);
  bf16*Ow=MIX+(rowbase+q0+wid*QBLK)*DMO+OC+h*D;
  { bf16*stg=(bf16*)(shm+LDS_OST)+wid*2048;
    #pragma unroll
    for(int r=0;r<16;++r){const int orow=crow(r,hi);
      #pragma unroll
      for(int d0=0;d0<2;++d0)stg[orow*64+d0*32+r32]=__float2bfloat16(o[d0][r]*rli[r]);}
    asm volatile("s_waitcnt lgkmcnt(0)":::"memory");
    #pragma unroll
    for(int i=0;i<4;++i){const int row=i*8+(lane>>3),ch=lane&7; const u32x4 v=*(const u32x4*)(stg+row*64+ch*8); *(u32x4*)(Ow+(long)row*DMO+ch*8)=v;} }
  asm volatile("s_waitcnt lgkmcnt(0)\n\ts_barrier":::"memory");
  #undef DMA_K
  #undef DMA_V
  #undef CMASK
  #undef ROT
}
constexpr int ATTN_LDS_BYTES=LDS_BYTES;
__device__ __forceinline__ void build_lut(char*shm){
  __attribute__((address_space(3))) float*bw=(__attribute__((address_space(3))) float*)((__attribute__((address_space(3))) char*)shm+LDS_LUT);
  for(int i=tid_opaque();i<LUT_N;i+=NW*64){ const int d=i-LUT_OFF; float v=-INFINITY;
    if(d>=0){ const int m=(d<=128?1:0)+(((d&3)==0&&d<=512)?1:0)+(((d&15)==0)?1:0); v=(m==0)?-INFINITY:(m==1?0.f:(m==2?1.0f:1.5849625007211562f)); }
    bw[i]=v; }
}
#undef SBAR
#undef WAIT_BAR
}

constexpr int NWAVES = 8;
constexpr int BATCH = 8, SEQ = 2048, D = 1024, T = BATCH * SEQ, NQKV = 3072, NINF = 3080, NE = 32, DE = 512, PLED = 256;
constexpr float RMS_EPS = 1e-6f, LOG2E = 1.4426950408889634f;
constexpr float C2 = 0.125f * 1.4426950408889634f;
constexpr int NPHASE = 9;

constexpr size_t MiB = 1u << 20;
constexpr size_t WS_CTL = 0, CTL_ZERO_BYTES = 64 * 1024;
constexpr size_t WS_WIN = 2 * MiB, WS_WO = 8 * MiB, WS_WPG = 10 * MiB, WS_WPP = 12 * MiB;
constexpr size_t WS_WRT = 12 * MiB + 512 * 1024  , WS_GAINS = 12 * MiB + 768 * 1024, WS_ROPE = 13 * MiB, WS_LOGF = 14 * MiB, WS_CUM = 14 * MiB + 512 * 1024, WS_LIDX = 15 * MiB;
constexpr size_t WS_LIST = 16 * MiB, WS_LISTW = 18 * MiB, WS_LISTR = 20 * MiB, WS_PB = 22 * MiB;
constexpr size_t WS_WUP = 32 * MiB, WS_WDN = 96 * MiB;
constexpr size_t WS_XN = 128 * MiB;
constexpr size_t WS_QKV = 160 * MiB;
constexpr size_t WS_H1 = 256 * MiB, WS_HG = 320 * MiB, WS_PLEB = 352 * MiB, WS_YB = 384 * MiB, WS_HID = 464 * MiB, WS_END = 504 * MiB;
constexpr int SLOT_ROWS = 40960;
constexpr int CW_CNT = 64, CW_QCTR = 128  , CW_DONE = 1024, CW_ERR = 2048;
constexpr int CW_BAR = 4096, CW_BARL = 11264;
static_assert(CW_BAR + 2 * 3456 <= CW_BARL && (CW_BARL + 2 * 2048) * 4 <= (int)CTL_ZERO_BYTES, "control words inside the memset region");

constexpr int RING_OFF = 0, RING_BYTES = 131072;
constexpr int RT_W_BYTES = 147456;
constexpr int LDSCTL_OFF = RT_W_BYTES, MISC_OFF = LDSCTL_OFF;
constexpr int L_CNT = LDSCTL_OFF + 128, L_TPRE = LDSCTL_OFF + 256, L_HIST = LDSCTL_OFF + 512, L_GBASE = LDSCTL_OFF + 640;
constexpr int L_PTAB = LDSCTL_OFF + 3072, L_QSLOT = LDSCTL_OFF + 3328;
constexpr int L_TOKE = LDSCTL_OFF + 768, L_TOKP = L_TOKE + 512, L_TOKW = L_TOKP + 512, L_TOKR = L_TOKW + 512;
constexpr int LDS_BYTES = LDSCTL_OFF + 4096;
static_assert(attn_body::ATTN_LDS_BYTES + NWAVES * 32 * 144 <= LDSCTL_OFF && L_TOKR + 256 <= L_PTAB && L_PTAB + 21 * 8 <= LDS_BYTES && LDS_BYTES <= 163840, "LDS map");

#define GAS __attribute__((address_space(1)))
#define LAS __attribute__((address_space(3)))
typedef unsigned short bf16;
typedef unsigned v4u __attribute__((ext_vector_type(4)));
typedef unsigned v2u __attribute__((ext_vector_type(2)));
typedef float f32x4 __attribute__((ext_vector_type(4)));
typedef GAS unsigned gu32;
#define RLX_AGENT __ATOMIC_RELAXED, __HIP_MEMORY_SCOPE_AGENT
#define LDS_WAIT() asm volatile("s_waitcnt lgkmcnt(0)" ::: "memory")
#define VM_WAIT() asm volatile("s_waitcnt vmcnt(0)" ::: "memory")
__device__ __forceinline__ unsigned f2bf(float f) { unsigned u = __builtin_bit_cast(unsigned, f); return (u + 0x7fffu + ((u >> 16) & 1u)) >> 16; }
typedef float pk_f32x2 __attribute__((ext_vector_type(2))); typedef __bf16 pk_bf16x2 __attribute__((ext_vector_type(2)));
__device__ __forceinline__ unsigned pk2(float lo, float hi) { const pk_f32x2 v = {lo, hi}; return __builtin_bit_cast(unsigned, __builtin_convertvector(v, pk_bf16x2)); }
__device__ __forceinline__ float bflo(unsigned w) { return __uint_as_float(w << 16); }
__device__ __forceinline__ float bfhi(unsigned w) { return __uint_as_float(w & 0xffff0000u); }

#define XB_TMO      128
#define XB_XCNT(j)  (256  + 64 * (j))
#define XB_XSUB(j)  (1280 + 64 * (j))
#define XB_XGEN(j)  (2304 + 64 * (j))
#define XB_TOP      3328
#define XB_TOPGEN   3392
#define XCD_BAR_WORDS 3456
#define XB_SPIN_CAP (1u << 18)
__device__ __forceinline__ unsigned xb_ld(unsigned* p)              { return __hip_atomic_load(p, __ATOMIC_RELAXED, __HIP_MEMORY_SCOPE_AGENT); }
__device__ __forceinline__ unsigned xb_add(unsigned* p, unsigned v) { return __hip_atomic_fetch_add(p, v, __ATOMIC_RELAXED, __HIP_MEMORY_SCOPE_AGENT); }
__device__ __forceinline__ unsigned xb_xcc_id() { return (unsigned)__builtin_amdgcn_s_getreg((3 << 11) | 20) & 0xFu; }
#define XB_SPIN(cond, bar) do { unsigned _sp = 0; while (cond) { __builtin_amdgcn_s_sleep(1); \
    if ((++_sp & 255u) == 0u) { if (xb_ld(&(bar)[XB_TMO])) break; if (_sp > XB_SPIN_CAP) { atomicAdd(&(bar)[XB_TMO], 1u); break; } } } } while (0)
#define XL_WORDS 2048
#define XL_SUB(j)   (64 * (j))
#define XL_GEN(j)   (1024 + 64 * (j))
struct XcdBarrier { unsigned* bar; unsigned* barl; unsigned x; volatile LAS unsigned* st; };
__device__ __forceinline__ void xcd_barrier_complete(unsigned* bar, unsigned x, unsigned& nloc, unsigned& nx) {
    const unsigned G = gridDim.x * gridDim.y * gridDim.z;
    unsigned sum, cnt, mine, sp = 0u;
    for (;;) {
        sum = 0u; cnt = 0u; mine = 0u;
#pragma unroll
        for (unsigned j = 0; j < 16; ++j) { const unsigned c = xb_ld(&bar[XB_XCNT(j)]); sum += c; cnt += (c > 0u) ? 1u : 0u; mine = (j == x) ? c : mine; }
        if (sum == G) break;
        __builtin_amdgcn_s_sleep(1);
        if ((++sp & 255u) == 0u) { if (xb_ld(&bar[XB_TMO])) break; if (sp > XB_SPIN_CAP) { atomicAdd(&bar[XB_TMO], 1u); break; } }
    }
    nloc = mine > 0u ? mine : 1u; nx = cnt > 0u ? cnt : 1u;
}
__device__ __forceinline__ XcdBarrier xcd_barrier_post(unsigned* bar, unsigned* barl, volatile LAS unsigned* st) {
    XcdBarrier b; b.bar = bar; b.barl = barl; b.x = xb_xcc_id(); b.st = st;
    if (threadIdx.x == 0) {
        const unsigned rank = xb_add(&bar[XB_XCNT(b.x)], 1u);
        unsigned nloc, nx; xcd_barrier_complete(bar, b.x, nloc, nx);
        const unsigned G = gridDim.x * gridDim.y * gridDim.z; unsigned ok = (G % 8u == 0u && nx == 8u) ? 1u : 0u;
#pragma unroll
        for (unsigned j = 0; j < 16; ++j) { const unsigned c = xb_ld(&bar[XB_XCNT(j)]); if (c != (j < 8u ? G / 8u : 0u)) ok = 0u; }
        if (xb_ld(&bar[XB_TMO])) ok = 0u;
        st[0] = nloc; st[1] = nx; st[2] = rank; st[3] = ok;
    }
    __syncthreads();
    return b;
}
__device__ __forceinline__ void xcdl_barrier(const XcdBarrier& b) {
    asm volatile("s_waitcnt vmcnt(0)" ::: "memory");
    __syncthreads();
    if (threadIdx.x == 0) {
        unsigned* bl = b.barl;
        __builtin_amdgcn_s_waitcnt(0);
        const unsigned nloc = b.st[0];
        const unsigned old = xb_add(&bl[XL_SUB(b.x)], 1u);
        const unsigned gen = old / nloc;
        if (old + 1u == (gen + 1u) * nloc) xb_add(&bl[XL_GEN(b.x)], 1u);
        else XB_SPIN(xb_ld(&bl[XL_GEN(b.x)]) == gen, b.bar);
        __builtin_amdgcn_fence(__ATOMIC_ACQUIRE, "agent");
        asm volatile("s_waitcnt vmcnt(0)" ::: "memory");
    }
    __syncthreads();
}
__device__ __forceinline__ void xcd_barrier(const XcdBarrier& b) {
    asm volatile("s_waitcnt vmcnt(0)" ::: "memory");
    __syncthreads();
    if (threadIdx.x == 0) {
        unsigned* bar = b.bar;
        __builtin_amdgcn_s_waitcnt(0);
        unsigned nloc = b.st[0], nx = b.st[1];
        if (nloc == 0u) { xcd_barrier_complete(bar, b.x, nloc, nx); b.st[0] = nloc; b.st[1] = nx; }
        const unsigned old = xb_add(&bar[XB_XSUB(b.x)], 1u);
        const unsigned gen = old / nloc;
        if (old + 1u == (gen + 1u) * nloc) {
            __builtin_amdgcn_fence(__ATOMIC_RELEASE, "agent");
            asm volatile("s_waitcnt vmcnt(0)" ::: "memory");
            const unsigned og = xb_add(&bar[XB_TOP], 1u);
            const unsigned tg = og / nx;
            if (og + 1u == (tg + 1u) * nx) xb_add(&bar[XB_TOPGEN], 1u);
            else XB_SPIN(xb_ld(&bar[XB_TOPGEN]) == tg, bar);
            __builtin_amdgcn_fence(__ATOMIC_ACQUIRE, "agent");
            xb_add(&bar[XB_XGEN(b.x)], 1u);
            asm volatile("s_waitcnt vmcnt(0)" ::: "memory");
        } else {
            XB_SPIN(xb_ld(&bar[XB_XGEN(b.x)]) == gen, bar);
            __builtin_amdgcn_fence(__ATOMIC_ACQUIRE, "agent");
            asm volatile("s_waitcnt vmcnt(0)" ::: "memory");
        }
    }
    __syncthreads();
}

__device__ __forceinline__ void xcd_barrier_arrive(const XcdBarrier& b) {
    asm volatile("s_waitcnt vmcnt(0)" ::: "memory");
    __syncthreads();
    if (threadIdx.x == 0) {
        unsigned* bar = b.bar;
        __builtin_amdgcn_s_waitcnt(0);
        const unsigned nloc = b.st[0], nx = b.st[1];
        const unsigned old = xb_add(&bar[XB_XSUB(b.x)], 1u);
        const unsigned gen = old / nloc;
        unsigned lead = 0u, tg = 0u;
        if (old + 1u == (gen + 1u) * nloc) {
            __builtin_amdgcn_fence(__ATOMIC_RELEASE, "agent");
            asm volatile("s_waitcnt vmcnt(0)" ::: "memory");
            const unsigned og = xb_add(&bar[XB_TOP], 1u);
            tg = og / nx; lead = 1u;
            if (og + 1u == (tg + 1u) * nx) xb_add(&bar[XB_TOPGEN], 1u);
        }
        b.st[4] = lead; b.st[5] = gen; b.st[6] = tg;
    }
}
__device__ __forceinline__ void xcd_barrier_wait(const XcdBarrier& b) {
    if (threadIdx.x == 0) {
        unsigned* bar = b.bar;
        const unsigned lead = b.st[4], gen = b.st[5], tg = b.st[6];
        if (lead) {
            XB_SPIN(xb_ld(&bar[XB_TOPGEN]) == tg, bar);
            __builtin_amdgcn_fence(__ATOMIC_ACQUIRE, "agent");
            xb_add(&bar[XB_XGEN(b.x)], 1u);
            asm volatile("s_waitcnt vmcnt(0)" ::: "memory");
        } else {
            XB_SPIN(xb_ld(&bar[XB_XGEN(b.x)]) == gen, bar);
            __builtin_amdgcn_fence(__ATOMIC_ACQUIRE, "agent");
            asm volatile("s_waitcnt vmcnt(0)" ::: "memory");
        }
    }
    __syncthreads();
}

struct Frame {
    LAS unsigned char* lds;
    volatile LAS unsigned* MISC;
    gu32* ctl;
    unsigned char* ws;
    float* out;
    int tid, lane, wave;
    int vcu, G, vblk, xl;
    __device__ __forceinline__ const float* in(int i) const {
        volatile LAS unsigned* t = (volatile LAS unsigned*)(lds + L_PTAB);
        const unsigned lo = (unsigned)__builtin_amdgcn_readfirstlane((int)t[2 * i]), hi = (unsigned)__builtin_amdgcn_readfirstlane((int)t[2 * i + 1]);
        return (const float*)(((unsigned long long)hi << 32) | lo);
    }
};
#define WSP(type, off) ((type*)(F.ws + (off)))
enum { I_X = 0, I_P, I_POS, I_GMIX, I_WIN, I_BF, I_QNA, I_KNA, I_QNB, I_KNB, I_WO, I_GFFN, I_WRG, I_BRG, I_WRE, I_BRE, I_WUP, I_WDN, I_GPLE, I_WPG, I_WPP };


__device__ __forceinline__ float wave_sum(float v) {
#pragma unroll
    for (int o = 1; o < 64; o <<= 1) v += __shfl_xor(v, o);
    return v;
}

template <int MAP> __device__ __forceinline__ int map_row(int n) {
    if (MAP == 1) { const int pn = n >> 8, r = n & 255, wc = r >> 6, bj = (r >> 5) & 1, j = r & 31; return 256 * pn + 128 * bj + 32 * wc + j; }
    if (MAP == 2) { const int bj = n >> 9, pn = (n >> 7) & 3, r = n & 127; return 256 * pn + 128 * bj + r; }
    return n;
}
constexpr int TP_STRIDE = 144, TP_BYTES = 64 * TP_STRIDE;
typedef short v4i16_t __attribute__((ext_vector_type(4)));
struct TpItem { const GAS float* src; bf16* dst; int ldn, K, kind, n0; };
__device__ __forceinline__ int map_row_rt(int kind, int n) {
    if (kind == 1) return (n & ~255) | (((n >> 5) & 1) << 7) | (((n >> 6) & 3) << 5) | (n & 31);
    if (kind == 2) return (((n >> 7) & 3) << 8) | ((n >> 9) << 7) | (n & 127);
    return n;
}
__device__ __forceinline__ void tp_load(const TpItem& t, f32x4 (&v)[16]) {
#pragma unroll
    for (int i = 0; i < 16; ++i) v[i] = __builtin_nontemporal_load((const GAS f32x4*)(t.src + (size_t)(4 * i) * t.ldn));
}
__device__ __forceinline__ void tp_store(const TpItem& t, const f32x4 (&v)[16], int lane, LAS unsigned char* scr) {
    const int kr = lane >> 4, nq = lane & 15;
#pragma unroll
    for (int i = 0; i < 16; ++i) { v2u w; w.x = pk2(v[i].x, v[i].y); w.y = pk2(v[i].z, v[i].w); *(LAS v2u*)(scr + (kr + 4 * i) * TP_STRIDE + nq * 8) = w; }
    LDS_WAIT(); asm volatile("" ::: "memory");
    const int g = lane >> 4, i16 = lane & 15, q = i16 >> 2, p = i16 & 3;
#pragma unroll
    for (int s = 0; s < 8; ++s) {
        const int C0 = 16 * (s >> 1), c = 4 * (s & 1) + g;
        const LAS unsigned char* rp = scr + (8 * c + q) * TP_STRIDE + (C0 + 4 * p) * 2;
        const v4i16_t lo = __builtin_amdgcn_ds_read_tr16_b64_v4i16((LAS v4i16_t*)rp), hi = __builtin_amdgcn_ds_read_tr16_b64_v4i16((LAS v4i16_t*)(rp + 4 * TP_STRIDE));
        const v2u a = __builtin_bit_cast(v2u, lo), b2 = __builtin_bit_cast(v2u, hi);
        v4u o; o.x = a.x; o.y = a.y; o.z = b2.x; o.w = b2.y;
        *(GAS v4u*)(t.dst + (size_t)(map_row_rt(t.kind, t.n0 + C0) + i16) * t.K + 8 * c) = o;
    }
    LDS_WAIT(); asm volatile("" ::: "memory");
}
__device__ __forceinline__ float rope_inv(int k) {
    const float INVF[8] = {1.000000000e+00f, 1.939227432e-01f, 3.760603070e-02f, 7.292664610e-03f, 1.414213562e-03f, 2.742481884e-04f, 5.318296098e-05f, 1.031338616e-05f};
    float r = INVF[0];
#pragma unroll
    for (int j = 1; j < 8; ++j) r = (k == j) ? INVF[j] : r;
    return r;
}
__device__ __forceinline__ void p0_prologue(Frame& F, const XcdBarrier& bar, const bool split) {
    const int gw = F.vcu * NWAVES + F.wave, NGW = F.G * NWAVES, lane = F.lane;
    const float* in_x = F.in(I_X); const float* in_p = F.in(I_P); const int* in_pos = (const int*)F.in(I_POS); const float* in_gmix = F.in(I_GMIX); const float* in_win = F.in(I_WIN); const float* in_bf = F.in(I_BF);
    bf16* XN = WSP(bf16, WS_XN); bf16* PB = WSP(bf16, WS_PB); float* LOGF = WSP(float, WS_LOGF); float* ROPE = WSP(float, WS_ROPE);
    LAS float* Wf = (LAS float*)(F.lds + RING_OFF);
    for (int i = F.tid; i < 1024 * 2; i += NWAVES * 64) { const int k = i >> 1, hf = i & 1; *(LAS f32x4*)(Wf + k * 8 + hf * 4) = *(const GAS f32x4*)((const GAS float*)in_win + (size_t)k * NINF + 3072 + hf * 4); }
    {
        const float* wrg = F.in(I_WRG); const float* wre = F.in(I_WRE); bf16* img = WSP(bf16, WS_WRT);
        const int per = (48 * 1024 + F.G - 1) / F.G;
        for (int i = F.tid; i < per; i += NWAVES * 64) { const int idx = F.vblk * per + i; if (idx < 48 * 1024) { const int n = idx >> 10, k = idx & 1023;
            float w = 0.f;
            if (n < 4) w = wrg[(size_t)k * 4 + n]; else if (n < 36) { const int g = (n - 4) >> 3, j = (n - 4) & 7; w = wre[((size_t)g * 1024 + k) * 8 + j]; }
            const unsigned hi = f2bf(w); const float lo = w - __uint_as_float(hi << 16);
            img[(size_t)n * 1024 + k] = (bf16)hi; img[(size_t)(48 + n) * 1024 + k] = (bf16)f2bf(lo); } }
    }
    if (F.vblk == 0 && F.tid < 256) { const int w = F.tid >> 6, l = F.tid & 63; const float* s = F.in(I_QNA + w); WSP(float, WS_GAINS)[F.tid] = s[l]; }
    __syncthreads();
    LAS unsigned char* tscr = F.lds + RING_OFF + 32768 + F.wave * TP_BYTES;
    constexpr int I_IN = 48 * 16, I_O = 16 * 16, I_PG = 16 * 16, I_PP = 16 * 4;
    constexpr int NITEMS = I_IN + I_O + I_PG + I_PP;
    const float* w_o = F.in(I_WO); const float* w_pg = F.in(I_WPG); const float* w_pp = F.in(I_WPP);
    auto decode = [&](int it) -> TpItem {
        int r = it; const float* W; bf16* WT; int ldn, K, kind, nb, kb;
        if (r < I_IN) { W = in_win; WT = WSP(bf16, WS_WIN); ldn = NINF; K = D; kind = 1; nb = r % 48; kb = r / 48; }
        else if ((r -= I_IN) < I_O) { W = w_o; WT = WSP(bf16, WS_WO); ldn = D; K = D; kind = 0; nb = r % 16; kb = r / 16; }
        else if ((r -= I_O) < I_PG) { W = w_pg; WT = WSP(bf16, WS_WPG); ldn = D; K = D; kind = 0; nb = r % 16; kb = r / 16; }
        else { r -= I_PG; W = w_pp; WT = WSP(bf16, WS_WPP); ldn = D; K = PLED; kind = 0; nb = r % 16; kb = r / 16; }
        TpItem t; t.ldn = ldn; t.K = K; t.kind = kind; t.n0 = nb * 64;
        t.src = (const GAS float*)W + (size_t)(kb * 64 + (lane >> 4)) * ldn + nb * 64 + 4 * (lane & 15); t.dst = WT + kb * 64; return t; };
    int it = gw;
    if (it < NITEMS) {
        TpItem A = decode(it), B = A; f32x4 va[16], vb[16]; tp_load(A, va);
        for (;;) {
            const int it2 = it + NGW; const bool has2 = it2 < NITEMS;
            if (has2) { B = decode(it2); tp_load(B, vb); }
            tp_store(A, va, lane, tscr);
            if (!has2) break;
            const int it3 = it2 + NGW; const bool has3 = it3 < NITEMS;
            if (has3) { A = decode(it3); tp_load(A, va); }
            tp_store(B, vb, lane, tscr);
            if (!has3) break;
            it = it3;
        }
    }

    if (split) xcd_barrier_arrive(bar);
    {
        f32x4 gm[4];
#pragma unroll
        for (int j = 0; j < 4; ++j) gm[j] = *(const GAS f32x4*)((const GAS float*)in_gmix + 4 * lane + 256 * j);
        constexpr int RB = 4;
        const int RPW = ((T + NGW - 1) / NGW + RB - 1) / RB * RB, mend = (gw + 1) * RPW < T ? (gw + 1) * RPW : T;
        for (int m0 = gw * RPW; m0 < mend; m0 += RB) {
            f32x4 v[RB][4], pv[RB]; float s2[RB];
#pragma unroll
            for (int r = 0; r < RB; ++r) { const GAS f32x4* xr = (const GAS f32x4*)(in_x + (size_t)(m0 + r) * D) + lane;
#pragma unroll
                for (int j = 0; j < 4; ++j) v[r][j] = xr[64 * j];
                pv[r] = *((const GAS f32x4*)(in_p + (size_t)(m0 + r) * PLED) + lane); }
#pragma unroll
            for (int r = 0; r < RB; ++r) { float s = 0.f;
#pragma unroll
                for (int j = 0; j < 4; ++j) s += (v[r][j].x * v[r][j].x + v[r][j].y * v[r][j].y) + (v[r][j].z * v[r][j].z + v[r][j].w * v[r][j].w);
                s2[r] = s; }
#pragma unroll
            for (int o = 1; o < 64; o <<= 1) {
#pragma unroll
                for (int r = 0; r < RB; ++r) s2[r] += __shfl_xor(s2[r], o); }
            float a[RB][8];
#pragma unroll
            for (int r = 0; r < RB; ++r) { const float rstd = 1.f / sqrtf(s2[r] * (1.f / D) + RMS_EPS);
                GAS unsigned long long* o8 = (GAS unsigned long long*)(XN + (size_t)(m0 + r) * D) + lane;
#pragma unroll
                for (int h = 0; h < 8; ++h) a[r][h] = 0.f;
#pragma unroll
                for (int j = 0; j < 4; ++j) { v[r][j] = v[r][j] * rstd * gm[j]; o8[64 * j] = (unsigned long long)pk2(v[r][j].x, v[r][j].y) | ((unsigned long long)pk2(v[r][j].z, v[r][j].w) << 32); }
                *((GAS unsigned long long*)(PB + (size_t)(m0 + r) * PLED) + lane) = (unsigned long long)pk2(pv[r].x, pv[r].y) | ((unsigned long long)pk2(pv[r].z, pv[r].w) << 32); }
#pragma unroll
            for (int j = 0; j < 4; ++j) { asm volatile("" ::: "memory");
#pragma unroll
                for (int c = 0; c < 4; ++c) { const int k = 4 * lane + 256 * j + c; const f32x4 w0 = *(const LAS f32x4*)(Wf + k * 8), w1 = *(const LAS f32x4*)(Wf + k * 8 + 4);
#pragma unroll
                    for (int r = 0; r < RB; ++r) { const float av = v[r][j][c];
                        a[r][0] += av * w0.x; a[r][1] += av * w0.y; a[r][2] += av * w0.z; a[r][3] += av * w0.w; a[r][4] += av * w1.x; a[r][5] += av * w1.y; a[r][6] += av * w1.z; a[r][7] += av * w1.w; } } }
            const bool b5 = lane & 32, b4 = lane & 16, b3 = lane & 8;
#pragma unroll
            for (int r = 0; r < RB; ++r) { const int m = m0 + r;
                float b[4], c2[2], d1;
#pragma unroll
                for (int i = 0; i < 4; ++i) { const float snd = b5 ? a[r][i] : a[r][i + 4], kp = b5 ? a[r][i + 4] : a[r][i]; b[i] = kp + __shfl_xor(snd, 32); }
#pragma unroll
                for (int i = 0; i < 2; ++i) { const float snd = b4 ? b[i] : b[i + 2], kp = b4 ? b[i + 2] : b[i]; c2[i] = kp + __shfl_xor(snd, 16); }
                { const float snd = b3 ? c2[0] : c2[1], kp = b3 ? c2[1] : c2[0]; d1 = kp + __shfl_xor(snd, 8); }
                d1 += __shfl_xor(d1, 4); d1 += __shfl_xor(d1, 2); d1 += __shfl_xor(d1, 1);
                if ((lane & 7) == 0) { const int h = lane >> 3; const float z = d1 + in_bf[h]; LOGF[(size_t)m * 8 + h] = fminf(z, 0.f) - log1pf(expf(-fabsf(z))); }
                if (lane < 8) { const float ang = (float)in_pos[m] * rope_inv(lane); double rv = (double)ang * 0.15915494309189535; rv -= rint(rv);
                    ROPE[(size_t)m * 16 + lane] = __builtin_amdgcn_cosf((float)rv); ROPE[(size_t)m * 16 + 8 + lane] = __builtin_amdgcn_sinf((float)rv); }
            }
        }
    }
}

constexpr int TPH_BYTES = 32 * TP_STRIDE;
__device__ __forceinline__ void tph_decode(Frame& F, int hi, int lane, const float* w_up, const float* w_dn, TpItem& t) {
    const float* W; bf16* WT; int ldn, K, kind, nb, kb;
    if (hi < NE * 32 * 16) { const int e = hi >> 9, q = hi & 511; W = w_up + (size_t)e * D * 1024; WT = WSP(bf16, WS_WUP) + (size_t)e * 1024 * D; ldn = 1024; K = D; kind = 2; nb = q & 15; kb = q >> 4; }
    else { const int r = hi - NE * 32 * 16, e = r >> 8, q = r & 255; W = w_dn + (size_t)e * DE * D; WT = WSP(bf16, WS_WDN) + (size_t)e * D * DE; ldn = D; K = DE; kind = 0; nb = q & 15; kb = q >> 4; }
    t.ldn = ldn; t.K = K; t.kind = kind; t.n0 = nb * 64;
    t.src = (const GAS float*)W + (size_t)(kb * 32 + (lane >> 4)) * ldn + nb * 64 + 4 * (lane & 15); t.dst = WT + kb * 32;
}
__device__ __forceinline__ void tph_load(const TpItem& t, f32x4 (&v)[8]) {
#pragma unroll
    for (int i = 0; i < 8; ++i) v[i] = __builtin_nontemporal_load((const GAS f32x4*)(t.src + (size_t)(4 * i) * t.ldn));
}
__device__ __forceinline__ void tph_store(const TpItem& t, const f32x4 (&v)[8], int lane, LAS unsigned char* scr) {
    const int kr = lane >> 4, nq = lane & 15;
#pragma unroll
    for (int i = 0; i < 8; ++i) { v2u w; w.x = pk2(v[i].x, v[i].y); w.y = pk2(v[i].z, v[i].w); *(LAS v2u*)(scr + (kr + 4 * i) * TP_STRIDE + nq * 8) = w; }
    LDS_WAIT(); asm volatile("" ::: "memory");
    const int g = lane >> 4, i16 = lane & 15, q = i16 >> 2, p = i16 & 3;
#pragma unroll
    for (int s = 0; s < 4; ++s) {
        const LAS unsigned char* rp = scr + (8 * g + q) * TP_STRIDE + (16 * s + 4 * p) * 2;
        const v4i16_t lo = __builtin_amdgcn_ds_read_tr16_b64_v4i16((LAS v4i16_t*)rp), hi = __builtin_amdgcn_ds_read_tr16_b64_v4i16((LAS v4i16_t*)(rp + 4 * TP_STRIDE));
        const v2u a = __builtin_bit_cast(v2u, lo), b2 = __builtin_bit_cast(v2u, hi);
        v4u o; o.x = a.x; o.y = a.y; o.z = b2.x; o.w = b2.y;
        __builtin_nontemporal_store(o, (GAS v4u*)(t.dst + (size_t)(map_row_rt(t.kind, t.n0 + 16 * s) + i16) * t.K + 8 * g));
    }
    LDS_WAIT(); asm volatile("" ::: "memory");
}
__device__ __forceinline__ void p2_convert_slot(Frame& F, int slot, int nslots, LAS unsigned char* scr) {
    const int tid = tid_opaque(), lane = tid & 63, wave = __builtin_amdgcn_readfirstlane(tid >> 6);
    const int gw = F.vcu * NWAVES + wave, NGW = F.G * NWAVES;
    constexpr int NHALF = NE * 32 * 16 + NE * 16 * 16;
    const float* w_up = F.in(I_WUP); const float* w_dn = F.in(I_WDN);
    LAS unsigned char* ws_ = scr + wave * TPH_BYTES;
    const int per = (NHALF + NGW - 1) / NGW;
    const int i0 = (slot * per) / nslots, i1 = ((slot + 1) * per) / nslots;
    for (int i = i0; i < i1; i += 6) {
        TpItem t[6]; f32x4 v[6][8]; bool ok[6];
#pragma unroll
        for (int q = 0; q < 6; ++q) { const int hq = gw + (i + q) * NGW; ok[q] = (i + q < i1) && hq < NHALF; if (ok[q]) { tph_decode(F, hq, lane, w_up, w_dn, t[q]); tph_load(t[q], v[q]); } }
#pragma unroll
        for (int q = 0; q < 6; ++q) if (ok[q]) tph_store(t[q], v[q], lane, ws_);
    }
}

__device__ __forceinline__ void p1_cumsum(Frame& F, int bh) {
    const int b = bh >> 3, h = bh & 7, tid = F.tid, lane = F.lane;
    const float* lf = WSP(float, WS_LOGF) + (size_t)b * SEQ * 8 + h;
    float v[4];
#pragma unroll
    for (int j = 0; j < 4; ++j) v[j] = lf[(size_t)(4 * tid + j) * 8] * LOG2E;
    v[1] += v[0]; v[2] += v[1]; v[3] += v[2];
    float inc = v[3];
#pragma unroll
    for (int o = 1; o < 64; o <<= 1) { const float u = __shfl_up(inc, o); if (lane >= o) inc += u; }
    volatile LAS float* wt = (volatile LAS float*)(F.lds + RING_OFF);
    if (lane == 63) wt[F.wave] = inc;
    __syncthreads();
    float off = inc - v[3];
    for (int w = 0; w < F.wave; ++w) off += wt[w];
    float* co = WSP(float, WS_CUM) + (size_t)bh * SEQ + 4 * tid;
#pragma unroll
    for (int j = 0; j < 4; ++j) co[j] = off + v[j];
    __syncthreads();
}

typedef short rbf16x8 __attribute__((ext_vector_type(8)));
__device__ __forceinline__ void split_hl(const f32x4 a, const f32x4 b, rbf16x8& hi, rbf16x8& lo) {
    const float v[8] = {a.x, a.y, a.z, a.w, b.x, b.y, b.z, b.w};
#pragma unroll
    for (int j = 0; j < 8; ++j) { const unsigned h = f2bf(v[j]); hi[j] = (short)h; lo[j] = (short)f2bf(v[j] - __uint_as_float(h << 16)); }
}
__device__ __forceinline__ void p3b_router(Frame& F) {
    const int tid = F.tid, lane = F.lane, wave = F.wave, r16 = lane & 15, kq = lane >> 4;
    const float* in_brg = F.in(I_BRG); const float* in_bre = F.in(I_BRE); const float* in_gffn = F.in(I_GFFN);
    const float* H1 = WSP(float, WS_H1); int* LIST = WSP(int, WS_LIST); int* LIDX = WSP(int, WS_LIDX); float* LISTW = WSP(float, WS_LISTW); float* LISTR = WSP(float, WS_LISTR);
    const bf16* img = WSP(bf16, WS_WRT);
    LAS float* part = (LAS float*)(F.lds);
    LAS float* pssq = (LAS float*)(F.lds + 98304);
    LAS float* logit = (LAS float*)(F.lds + 98304 + 2048);
    LAS float* tssq = (LAS float*)(F.lds + 98304 + 2048 + 12288);
    volatile LAS int* hist = (volatile LAS int*)(F.lds + L_HIST);
    volatile LAS int* gbase = (volatile LAS int*)(F.lds + L_GBASE);
    volatile LAS int* tokE = (volatile LAS int*)(F.lds + L_TOKE);
    volatile LAS float* tokW = (volatile LAS float*)(F.lds + L_TOKW);
    volatile LAS float* tokR = (volatile LAS float*)(F.lds + L_TOKR);
    if (tid < 32) hist[tid] = 0;
    const int kb = wave * 128 + kq * 8;
    rbf16x8 bh[4][3], bl[4][3]; f32x4 gv[4][2];
#pragma unroll
    for (int s = 0; s < 4; ++s) {
#pragma unroll
        for (int nb = 0; nb < 3; ++nb) { bh[s][nb] = *(const GAS rbf16x8*)(img + (size_t)(nb * 16 + r16) * 1024 + kb + 32 * s); bl[s][nb] = *(const GAS rbf16x8*)(img + (size_t)(48 + nb * 16 + r16) * 1024 + kb + 32 * s); }
        gv[s][0] = *(const GAS f32x4*)((const GAS float*)in_gffn + kb + 32 * s); gv[s][1] = *(const GAS f32x4*)((const GAS float*)in_gffn + kb + 32 * s + 4); }
    for (int grp = F.vcu; grp < T / 64; grp += F.G) {
#pragma unroll
        for (int tb = 0; tb < 4; ++tb) {
            const GAS float* hr = (const GAS float*)H1 + (size_t)(grp * 64 + tb * 16 + r16) * D + kb;
            f32x4 acc[3] = {(f32x4){0.f, 0.f, 0.f, 0.f}, (f32x4){0.f, 0.f, 0.f, 0.f}, (f32x4){0.f, 0.f, 0.f, 0.f}}; float s2 = 0.f;
            f32x4 h0[4], h1v[4];
#pragma unroll
            for (int s = 0; s < 4; ++s) { h0[s] = *(const GAS f32x4*)(hr + 32 * s); h1v[s] = *(const GAS f32x4*)(hr + 32 * s + 4); }
#pragma unroll
            for (int s = 0; s < 4; ++s) {
                s2 += (h0[s].x * h0[s].x + h0[s].y * h0[s].y) + (h0[s].z * h0[s].z + h0[s].w * h0[s].w) + (h1v[s].x * h1v[s].x + h1v[s].y * h1v[s].y) + (h1v[s].z * h1v[s].z + h1v[s].w * h1v[s].w);
                rbf16x8 ah, al; split_hl(h0[s] * gv[s][0], h1v[s] * gv[s][1], ah, al);
#pragma unroll
                for (int nb = 0; nb < 3; ++nb) {
                    acc[nb] = __builtin_amdgcn_mfma_f32_16x16x32_bf16(ah, bh[s][nb], acc[nb], 0, 0, 0);
                    acc[nb] = __builtin_amdgcn_mfma_f32_16x16x32_bf16(ah, bl[s][nb], acc[nb], 0, 0, 0);
                    acc[nb] = __builtin_amdgcn_mfma_f32_16x16x32_bf16(al, bh[s][nb], acc[nb], 0, 0, 0); }
            }
            s2 += __shfl_xor(s2, 16); s2 += __shfl_xor(s2, 32);
            if (kq == 0) pssq[wave * 64 + tb * 16 + r16] = s2;
#pragma unroll
            for (int nb = 0; nb < 3; ++nb)
#pragma unroll
                for (int r = 0; r < 4; ++r) part[(wave * 64 + tb * 16 + 4 * kq + r) * 48 + nb * 16 + r16] = acc[nb][r];
        }
        __syncthreads();
        for (int i = tid; i < 64 * 48; i += NWAVES * 64) { float s = 0.f;
#pragma unroll
            for (int w = 0; w < 8; ++w) s += part[w * 3072 + i];
            logit[i] = s; }
        if (tid < 64) { float s = 0.f;
#pragma unroll
            for (int w = 0; w < 8; ++w) s += pssq[w * 64 + tid];
            tssq[tid] = s; }
        __syncthreads();
        if (tid < 64) {
            const float rs = 1.f / sqrtf(tssq[tid] * (1.f / D) + RMS_EPS); const LAS float* lt = logit + tid * 48;
            float lg[4];
#pragma unroll
            for (int g = 0; g < 4; ++g) lg[g] = lt[g] * rs + in_brg[g];
            int gi = 0; float gm = lg[0];
#pragma unroll
            for (int g = 1; g < 4; ++g) if (lg[g] > gm) { gm = lg[g]; gi = g; }
            float den = 0.f;
#pragma unroll
            for (int g = 0; g < 4; ++g) den += expf(lg[g] - gm);
            const float gw = 1.0f / den;
            float le[8];
#pragma unroll
            for (int j = 0; j < 8; ++j) le[j] = lt[4 + 8 * gi + j] * rs + in_bre[gi * 8 + j];
            int i0 = 0; float v0 = le[0];
#pragma unroll
            for (int j = 1; j < 8; ++j) if (le[j] > v0) { v0 = le[j]; i0 = j; }
            int i1 = -1; float v1 = -3.4e38f;
#pragma unroll
            for (int j = 0; j < 8; ++j) if (j != i0 && le[j] > v1) { v1 = le[j]; i1 = j; }
            const float e1 = expf(v1 - v0), sden = 1.0f / (1.0f + e1);
            tokE[2 * tid] = gi * 8 + i0; tokE[2 * tid + 1] = gi * 8 + i1; tokW[2 * tid] = gw * sden; tokW[2 * tid + 1] = gw * e1 * sden; tokR[tid] = rs;
        }
        __syncthreads();
        int e = 0, pl = 0;
        if (tid < 128) { e = tokE[tid]; pl = __hip_atomic_fetch_add((LAS int*)hist + e, 1, __ATOMIC_RELAXED, __HIP_MEMORY_SCOPE_WORKGROUP); }
        __syncthreads();
        if (tid < 32) { const int hc = hist[tid]; gbase[tid] = hc ? (int)__hip_atomic_fetch_add((unsigned*)(F.ctl + CW_CNT + tid), (unsigned)hc, RLX_AGENT) : 0; }
        __syncthreads();
        if (tid < 128) { const int pos = gbase[e] + pl, tok = grp * 64 + (tid >> 1); const size_t li = (size_t)e * T + pos;
            LIST[li] = tok * 2 + (tid & 1); LISTW[li] = tokW[tid]; LISTR[li] = tokR[tid >> 1]; LIDX[tok * 2 + (tid & 1)] = (int)li; }
        __syncthreads();
        if (tid < 32) hist[tid] = 0;
        __syncthreads();
    }
}

__device__ __forceinline__ void load_expert_table(Frame& F) {
    volatile LAS int* cnt = (volatile LAS int*)(F.lds + L_CNT); volatile LAS int* tpre = (volatile LAS int*)(F.lds + L_TPRE);
    if (F.tid < 32) cnt[F.tid] = (int)__hip_atomic_load(F.ctl + CW_CNT + F.tid, RLX_AGENT);
    __syncthreads();
    if (F.tid == 0) { int s = 0; for (int e = 0; e < 32; ++e) { tpre[e] = s; s += (cnt[e] + 255) >> 8; } tpre[32] = s; }
    __syncthreads();
}

__device__ __forceinline__ void p6a_rows(Frame& F) {
    const int gw = F.vcu * NWAVES + F.wave, NGW = F.G * NWAVES, lane = F.lane;
    volatile LAS int* tpre = (volatile LAS int*)(F.lds + L_TPRE);
    const float* in_gple = F.in(I_GPLE); const int* LIDX = WSP(int, WS_LIDX); const float* H1 = WSP(float, WS_H1); const bf16* YB = WSP(bf16, WS_YB); bf16* HN = WSP(bf16, WS_XN);
    f32x4 gp[4];
#pragma unroll
    for (int j = 0; j < 4; ++j) gp[j] = *(const GAS f32x4*)((const GAS float*)in_gple + 4 * lane + 256 * j);
    const int RPW = (T + NGW - 1) / NGW, mend = (gw + 1) * RPW < T ? (gw + 1) * RPW : T;
    constexpr int RB = 2;
    for (int m0 = gw * RPW; m0 < mend; m0 += RB) {
        int i0[RB], i1[RB];
#pragma unroll
        for (int r = 0; r < RB; ++r) { const int m = (m0 + r < mend) ? m0 + r : mend - 1; i0[r] = LIDX[2 * m]; i1[r] = LIDX[2 * m + 1]; }
        f32x4 hv[RB][4]; v2u ya[RB][4], yb[RB][4];
#pragma unroll
        for (int r = 0; r < RB; ++r) { const int m = (m0 + r < mend) ? m0 + r : mend - 1;
            const size_t s0 = (size_t)tpre[i0[r] >> 14] * 256 + (i0[r] & 16383), s1 = (size_t)tpre[i1[r] >> 14] * 256 + (i1[r] & 16383);
            const GAS f32x4* hr = (const GAS f32x4*)(H1 + (size_t)m * D) + lane;
            const GAS v2u* y0 = (const GAS v2u*)(YB + s0 * D) + lane; const GAS v2u* y1 = (const GAS v2u*)(YB + s1 * D) + lane;
#pragma unroll
            for (int j = 0; j < 4; ++j) { hv[r][j] = hr[64 * j]; ya[r][j] = y0[64 * j]; yb[r][j] = y1[64 * j]; } }
#pragma unroll
        for (int r = 0; r < RB; ++r) { if (m0 + r < mend) { const int m = m0 + r;
            f32x4 v[4]; float s2 = 0.f;
#pragma unroll
            for (int j = 0; j < 4; ++j) { const f32x4 h = hv[r][j]; const v2u a = ya[r][j], b = yb[r][j];
                v[j].x = h.x + (bflo(a.x) + bflo(b.x)); v[j].y = h.y + (bfhi(a.x) + bfhi(b.x)); v[j].z = h.z + (bflo(a.y) + bflo(b.y)); v[j].w = h.w + (bfhi(a.y) + bfhi(b.y));
                s2 += (v[j].x * v[j].x + v[j].y * v[j].y) + (v[j].z * v[j].z + v[j].w * v[j].w); }
            const float rstd = 1.f / sqrtf(wave_sum(s2) * (1.f / D) + RMS_EPS);
            GAS unsigned long long* h8 = (GAS unsigned long long*)(WSP(bf16, WS_QKV) + (size_t)m * D) + lane;
            GAS unsigned long long* o8 = (GAS unsigned long long*)(HN + (size_t)m * D) + lane;
#pragma unroll
            for (int j = 0; j < 4; ++j) { h8[64 * j] = (unsigned long long)pk2(v[j].x, v[j].y) | ((unsigned long long)pk2(v[j].z, v[j].w) << 32);
                const f32x4 n = v[j] * rstd * gp[j]; o8[64 * j] = (unsigned long long)pk2(n.x, n.y) | ((unsigned long long)pk2(n.z, n.w) << 32); } } }
    }
}

struct Args { const float* in[21]; float* out; unsigned char* ws; int ph_lo, ph_hi, li, pad; };
__global__ void __launch_bounds__(NWAVES * 64, 2) mega_fwd(Args args) {
    extern __shared__ __attribute__((aligned(16))) unsigned char lds[];
    Frame F;
    F.lds = (LAS unsigned char*)lds;
    F.MISC = (volatile LAS unsigned*)(F.lds + MISC_OFF);
    F.tid = threadIdx.x; F.lane = F.tid & 63; F.wave = __builtin_amdgcn_readfirstlane(F.tid >> 6);
    F.G = gridDim.x;
    F.ws = args.ws; F.out = args.out; F.ctl = (gu32*)(args.ws + WS_CTL);
    for (int u = F.tid; u < (LDS_BYTES - LDSCTL_OFF) / 4; u += NWAVES * 64) ((LAS unsigned*)(F.lds + LDSCTL_OFF))[u] = 0u;
    __syncthreads();
    if (F.tid < 21) { const unsigned long long pv = (unsigned long long)args.in[F.tid]; volatile LAS unsigned* t = (volatile LAS unsigned*)(F.lds + L_PTAB); t[2 * F.tid] = (unsigned)pv; t[2 * F.tid + 1] = (unsigned)(pv >> 32); }
    __syncthreads();
    const XcdBarrier bar = xcd_barrier_post((unsigned*)(F.ctl + CW_BAR) + args.li * XCD_BAR_WORDS, (unsigned*)(F.ctl + CW_BARL) + args.li * XL_WORDS, F.MISC + 8);
    F.xl = (int)F.MISC[8 + 3];
    { const int bx = F.xl ? (int)F.MISC[8 + 2] * 8 + (int)bar.x : (int)blockIdx.x; F.vblk = bx; F.vcu = (F.G % 8 == 0) ? (bx % 8) * (F.G / 8) + bx / 8 : bx; }
#define GRID_BAR() xcd_barrier(bar)
#define SEAM_BAR(k) do { if (F.xl && ((k) == 1 || (k) == 2 || (k) == 3 || (k) == 7)) xcdl_barrier(bar); else xcd_barrier(bar); } while (0)
    const int lo = args.ph_lo, hi = args.ph_hi;
#define IN(k) (lo <= (k) && (k) < hi)
#define BOTH(k) (IN(k) && IN((k) + 1))
#define PHASE_BEGIN() do { const int t_ = tid_opaque(); F.tid = t_; F.lane = t_ & 63; F.wave = __builtin_amdgcn_readfirstlane(t_ >> 6); } while (0)
    volatile LAS int* l_cnt = (volatile LAS int*)(F.lds + L_CNT); volatile LAS int* l_tpre = (volatile LAS int*)(F.lds + L_TPRE);

#define PHASE(k, ...) if (IN(k)) { PHASE_BEGIN(); __VA_ARGS__ if (BOTH(k)) SEAM_BAR(k); }
    if (IN(0)) { PHASE_BEGIN(); const bool split = F.xl && BOTH(0); p0_prologue(F, bar, split);
        if (BOTH(0)) { if (split) { xcdl_barrier(bar); xcd_barrier_wait(bar); } else GRID_BAR(); } }

    const bool ple_early = F.xl && (bar.x & 1u) && IN(1) && IN(4);
    PHASE(1,
        if (ple_early) {
          pg8::SrcDense g{WSP(bf16, WS_PB), WSP(bf16, WS_WPP), PLED}; pg8::StaticOrder S; S.init(T, D, F.G, F.vblk);
          pg8::EpiBf16 E{WSP(bf16, WS_PLEB), D};
          pg8::gemm_phase<pg8::EpiBf16, pg8::StaticOrder, pg8::SrcDense, true, true>(F.lds + RING_OFF, PLED, S, g, E);
          PHASE_BEGIN(); }
        if (F.G % 8 == 0 && F.G >= 64) { const int per = F.G / 8; if (F.vcu % per < 8) p1_cumsum(F, (F.vcu / per) * 8 + F.vcu % per); }
        else for (int bh = F.vblk; bh < 64; bh += F.G) p1_cumsum(F, bh);
        pg8::SrcDense g{WSP(bf16, WS_XN), WSP(bf16, WS_WIN), D}; pg8::StaticOrder S; S.init(T, NQKV, F.G, F.vblk);
        pg8::EpiQKV E{WSP(bf16, WS_QKV), WSP(float, WS_GAINS), WSP(float, WS_ROPE), C2};
        pg8::gemm_phase<pg8::EpiQKV, pg8::StaticOrder, pg8::SrcDense, true, true>(F.lds + RING_OFF, D, S, g, E);
    )

    PHASE(2,
        LAS unsigned char* cscr = F.lds + RING_OFF + attn_body::ATTN_LDS_BYTES;
        attn_body::build_lut((char*)lds + RING_OFF);
        const attn_body::bf16* qkv = (const attn_body::bf16*)WSP(bf16, WS_QKV); attn_body::bf16* mixo = (attn_body::bf16*)WSP(bf16, WS_XN); const float* cum = WSP(float, WS_CUM);
        const int spm = ((F.vcu >> 2) & 1) ? 0x14 : 0x0A;
        const int sp = 0; (void)sp;
        int cs = 0, un = 0;
        auto unit_of = [&](const int j, int& kind, int& b, int& h, int& qb) -> bool {
            const int I = F.vcu + (j >> 1) * F.G; if (I >= 512) return false;
            kind = I >> 8; const int v = I & 255, bh = v >> 2, s = v & 3; b = bh >> 3; h = bh & 7; qb = (j & 1) ? 7 - s : s; return true; };
        attn_body::bf16x8 qio[4]; bool pre = false;
        if (spm & 1) p2_convert_slot(F, cs++, 2, cscr);
        _Pragma("unroll 1")
        for (int j = 0;; ++j) {
            int kind, b, h, qb; if (!unit_of(j, kind, b, h, qb)) break;
            const bool slot_after = cs < 2 && ((spm >> (un + 1)) & 1);
            int nk, nb, nh, nqb; const bool chain = unit_of(j + 1, nk, nb, nh, nqb) && !slot_after;
            const attn_body::bf16* nQ = nullptr; const attn_body::bf16* nK = nullptr;
            if (chain) attn_body::next_ptrs(nk, nb, nh, nqb, qkv, nQ, nK);
            if (kind == 0) attn_body::attn_unit<0>(b, h, qb, qkv, cum, mixo, (char*)lds + RING_OFF, pre, qio, nQ, nK);
            else           attn_body::attn_unit<1>(b, h, qb, qkv, cum, mixo, (char*)lds + RING_OFF, pre, qio, nQ, nK);
            pre = chain;
            if (slot_after) p2_convert_slot(F, cs++, 2, cscr);
            ++un;
        }
        while (cs < 2) p2_convert_slot(F, cs++, 2, cscr);
    )

    PHASE(3,
        { pg8::SrcDense g{WSP(bf16, WS_XN), WSP(bf16, WS_WO), D}; pg8::StaticOrder S; S.init(T, D, F.G, F.vblk);
          pg8::EpiRes E{F.in(I_X), WSP(float, WS_H1), WSP(bf16, WS_HG), F.in(I_GFFN)};
          pg8::gemm_phase<pg8::EpiRes, pg8::StaticOrder, pg8::SrcDense, true, true>(F.lds + RING_OFF, D, S, g, E); }
    )

    if (IN(4)) { PHASE_BEGIN(); p3b_router(F);
        if (BOTH(4)) xcd_barrier_arrive(bar);
        if (!ple_early) { PHASE_BEGIN();
          pg8::SrcDense g{WSP(bf16, WS_PB), WSP(bf16, WS_WPP), PLED}; pg8::StaticOrder S; S.init(T, D, F.G, F.vblk);
          pg8::EpiBf16 E{WSP(bf16, WS_PLEB), D};
          pg8::gemm_phase<pg8::EpiBf16, pg8::StaticOrder, pg8::SrcDense, true, true>(F.lds + RING_OFF, PLED, S, g, E); }
        if (BOTH(4)) xcd_barrier_wait(bar); }

    PHASE(5,
        load_expert_table(F);
        pg8::MoeArgs M{WSP(bf16, WS_HG), WSP(bf16, WS_WUP), WSP(bf16, WS_HID), WSP(bf16, WS_WDN), WSP(bf16, WS_YB), WSP(int, WS_LIST), WSP(float, WS_LISTR), WSP(float, WS_LISTW),
                       (unsigned*)(F.ctl + CW_QCTR), (unsigned*)(F.ctl + CW_DONE), (unsigned*)(F.ctl + CW_ERR), l_tpre, l_cnt, (volatile LAS int*)(F.lds + L_QSLOT), T, (F.G % 8 == 0) ? (F.vcu / (F.G / 8)) & 7 : (int)(blockIdx.x & 7)};
        pg8::moe_phase(F.lds + RING_OFF, M);
    )

    PHASE(7, load_expert_table(F); p6a_rows(F);)

    PHASE(8,
        pg8::SrcDense g{WSP(bf16, WS_XN), WSP(bf16, WS_WPG), D}; pg8::StaticOrder S; S.init(T, D, F.G, F.vblk);
        pg8::EpiFinal E{F.out, WSP(bf16, WS_PLEB), WSP(bf16, WS_QKV)};
        pg8::gemm_phase<pg8::EpiFinal, pg8::StaticOrder, pg8::SrcDense, true, true>(F.lds + RING_OFF, D, S, g, E);
    )
#undef PHASE
#undef IN
#undef BOTH
#undef GRID_BAR
}

extern "C" void kernel_launch(void* const* d_in, const int* in_sizes, int n_in, void* d_out, int out_size, void* d_ws, size_t ws_size, hipStream_t stream) {
    static int grid = 0;
    if (grid == 0) {
        if (n_in != 21 || out_size != T * D || ws_size < WS_END) { fprintf(stderr, "kernel_launch: unexpected problem (n_in %d, out %d, ws %zu)\n", n_in, out_size, ws_size); grid = -1; return; }
        int dev = 0, cus = 0;
        if (hipGetDevice(&dev) != hipSuccess || hipDeviceGetAttribute(&cus, hipDeviceAttributeMultiprocessorCount, dev) != hipSuccess) { grid = -1; return; }
        if (hipFuncSetAttribute((const void*)mega_fwd, hipFuncAttributeMaxDynamicSharedMemorySize, LDS_BYTES) != hipSuccess) { fprintf(stderr, "kernel_launch: hipFuncSetAttribute failed\n"); grid = -1; return; }
        (void)hipGetLastError();
        grid = cus;
    }
    if (grid < 0) return;
    (void)hipMemsetAsync((char*)d_ws + WS_CTL, 0, CTL_ZERO_BYTES, stream);
    Args a{};
    for (int i = 0; i < 21; ++i) a.in[i] = (const float*)d_in[i];
    a.out = (float*)d_out; a.ws = (unsigned char*)d_ws;
    a.ph_lo = 0; a.ph_hi = NPHASE; a.li = 0;
    hipLaunchKernelGGL(mega_fwd, dim3(grid), dim3(NWAVES * 64), LDS_BYTES, stream, a);

}
```
